# Optimizing an MI355X kernel written in HIP

```python
import math
import jax, jax.numpy as jnp
from jax import lax
import numpy as np

D_MODEL = 2048
BATCH = 4
SEQ = 4096
DEPTH = 1

D_SSM = D_MODEL // 2
SSM_GROUP = 16
N_SSM_GROUPS = D_SSM // SSM_GROUP
SSM_STATE = 64
D_GMLP = D_MODEL - D_SSM
GMLP_HEAD = 128
N_GMLP_HEADS = D_GMLP // GMLP_HEAD
CHUNK = 128
D_IN = D_SSM + 2 * D_GMLP
D_FF = 5632
D_PLE = 256
EPS = 1e-6
DT_MIN = 1e-3
DT_MAX = 1e-1

kernel_name = "hybrid_s5_gmlp_macaron_ple"


def rms_norm(x, g):
    xf = x.astype(jnp.float32)
    y = xf * lax.rsqrt(jnp.mean(xf * xf, axis=-1, keepdims=True) + EPS) * g.astype(jnp.float32)
    return y.astype(x.dtype)


def layer_norm(x, g):
    xf = x.astype(jnp.float32)
    xc = xf - jnp.mean(xf, axis=-1, keepdims=True)
    y = xc * lax.rsqrt(jnp.mean(xc * xc, axis=-1, keepdims=True) + EPS) * g.astype(jnp.float32)
    return y.astype(x.dtype)


def swiglu(x, w_gate, w_up, w_down):
    return (jax.nn.silu(x @ w_gate) * (x @ w_up)) @ w_down


def _complex_affine_combine(e1, e2):
    a1r, a1i, b1r, b1i = e1
    a2r, a2i, b2r, b2i = e2
    return (a2r * a1r - a2i * a1i,
            a2r * a1i + a2i * a1r,
            a2r * b1r - a2i * b1i + b2r,
            a2r * b1i + a2i * b1r + b2i)


def s5_mixer(u, log_dt, a_re, a_im, b_re, b_im, c_re, c_im, d, w_glu):
    bsz, seqlen, _ = u.shape
    f32 = jnp.float32
    uf = u.astype(f32).reshape(bsz, seqlen, N_SSM_GROUPS, SSM_GROUP)
    dt = jnp.exp(log_dt.astype(f32))[:, None]
    lr = jnp.minimum(a_re.astype(f32), -1e-4)
    li = a_im.astype(f32)
    mag = jnp.exp(lr * dt)
    ang = li * dt
    abar_r = mag * jnp.cos(ang)
    abar_i = mag * jnp.sin(ang)
    den = lr * lr + li * li
    xr = abar_r - 1.0
    xi = abar_i
    zr = (xr * lr + xi * li) / den
    zi = (xi * lr - xr * li) / den
    br = b_re.astype(f32)
    bi = b_im.astype(f32)
    bbar_r = zr[..., None] * br - zi[..., None] * bi
    bbar_i = zr[..., None] * bi + zi[..., None] * br
    drive_r = jnp.einsum("blgp,gnp->lbgn", uf, bbar_r)
    drive_i = jnp.einsum("blgp,gnp->lbgn", uf, bbar_i)
    ar = jnp.broadcast_to(abar_r[None, None], (seqlen, 1, N_SSM_GROUPS, SSM_STATE))
    ai = jnp.broadcast_to(abar_i[None, None], (seqlen, 1, N_SSM_GROUPS, SSM_STATE))
    _, _, sr, si = lax.associative_scan(_complex_affine_combine, (ar, ai, drive_r, drive_i), axis=0)
    y = (jnp.einsum("lbgn,gpn->blgp", sr, c_re.astype(f32))
         - jnp.einsum("lbgn,gpn->blgp", si, c_im.astype(f32)))
    y = y + d.astype(f32).reshape(N_SSM_GROUPS, SSM_GROUP) * uf
    y = jax.nn.gelu(y.reshape(bsz, seqlen, D_SSM))
    y = y * jax.nn.sigmoid(y @ w_glu.astype(f32))
    return y.astype(u.dtype)


def gmlp_mixer(z_u, z_v, norm_v, w_s, b_s):
    bsz, seqlen, _ = z_u.shape
    n_chunks = seqlen // CHUNK
    u = jax.nn.gelu(z_u)
    v = layer_norm(jax.nn.gelu(z_v), norm_v)
    causal = jnp.tril(jnp.ones((CHUNK, CHUNK), dtype=bool))
    w = jnp.where(causal[None], w_s, jnp.zeros_like(w_s))
    vc = v.reshape(bsz, n_chunks, CHUNK, N_GMLP_HEADS, GMLP_HEAD)
    s = jnp.einsum("hts,bcshp->bcthp", w, vc) + b_s.T[None, None, :, :, None]
    out = u.reshape(bsz, n_chunks, CHUNK, N_GMLP_HEADS, GMLP_HEAD) * s
    return out.reshape(bsz, seqlen, D_GMLP)


def setup_inputs(seed: int = 0) -> dict:
    key = jax.random.key(seed)
    ks = jax.random.split(key, 32)
    f32 = jnp.float32

    def nrm(k, shape, std):
        return (jax.random.normal(k, shape, f32) * std).astype(f32)

    def gain(k, shape):
        return 1.0 + nrm(k, shape, 0.02)

    L = DEPTH
    x = nrm(ks[0], (BATCH, SEQ, D_MODEL), 1.0)
    p = nrm(ks[1], (L, BATCH, SEQ, D_PLE), 1.0)
    n_idx = jnp.arange(SSM_STATE, dtype=f32)
    return {
        "x": x,
        "p": p,
        "norm_ffn1": gain(ks[2], (L, D_MODEL)),
        "w1_gate": nrm(ks[3], (L, D_MODEL, D_FF), D_MODEL ** -0.5),
        "w1_up": nrm(ks[4], (L, D_MODEL, D_FF), D_MODEL ** -0.5),
        "w1_down": nrm(ks[5], (L, D_FF, D_MODEL), D_FF ** -0.5),
        "norm_mix": gain(ks[6], (L, D_MODEL)),
        "w_in": nrm(ks[7], (L, D_MODEL, D_IN), D_MODEL ** -0.5),
        "ssm_log_dt": jax.random.uniform(ks[8], (L, N_SSM_GROUPS), f32, math.log(DT_MIN), math.log(DT_MAX)),
        "ssm_a_re": -0.5 + nrm(ks[9], (L, N_SSM_GROUPS, SSM_STATE), 0.01),
        "ssm_a_im": math.pi * n_idx[None, None, :] + nrm(ks[10], (L, N_SSM_GROUPS, SSM_STATE), 0.01),
        "ssm_b_re": nrm(ks[11], (L, N_SSM_GROUPS, SSM_STATE, SSM_GROUP), (2 * SSM_GROUP) ** -0.5),
        "ssm_b_im": nrm(ks[12], (L, N_SSM_GROUPS, SSM_STATE, SSM_GROUP), (2 * SSM_GROUP) ** -0.5),
        "ssm_c_re": nrm(ks[13], (L, N_SSM_GROUPS, SSM_GROUP, SSM_STATE), 0.5 ** 0.5),
        "ssm_c_im": nrm(ks[14], (L, N_SSM_GROUPS, SSM_GROUP, SSM_STATE), 0.5 ** 0.5),
        "ssm_d": nrm(ks[15], (L, D_SSM), 1.0),
        "ssm_w_glu": nrm(ks[16], (L, D_SSM, D_SSM), D_SSM ** -0.5),
        "gmlp_norm_v": gain(ks[17], (L, D_GMLP)),
        "gmlp_w_s": nrm(ks[18], (L, N_GMLP_HEADS, CHUNK, CHUNK), CHUNK ** -0.5),
        "gmlp_b_s": 1.0 + nrm(ks[19], (L, N_GMLP_HEADS, CHUNK), 0.01),
        "norm_ssm_out": gain(ks[20], (L, D_SSM)),
        "norm_gmlp_out": gain(ks[21], (L, D_GMLP)),
        "w_out": nrm(ks[22], (L, D_MODEL, D_MODEL), D_MODEL ** -0.5),
        "norm_ffn2": gain(ks[23], (L, D_MODEL)),
        "w2_gate": nrm(ks[24], (L, D_MODEL, D_FF), D_MODEL ** -0.5),
        "w2_up": nrm(ks[25], (L, D_MODEL, D_FF), D_MODEL ** -0.5),
        "w2_down": nrm(ks[26], (L, D_FF, D_MODEL), D_FF ** -0.5),
        "norm_ple": gain(ks[27], (L, D_MODEL)),
        "w_ple_gate": nrm(ks[28], (L, D_MODEL, D_MODEL), D_MODEL ** -0.5),
        "w_ple_proj": nrm(ks[29], (L, D_PLE, D_MODEL), D_PLE ** -0.5),
        "norm_final": gain(ks[30], (D_MODEL,)),
    }


def reference(x, p, norm_ffn1, w1_gate, w1_up, w1_down, norm_mix, w_in,
              ssm_log_dt, ssm_a_re, ssm_a_im, ssm_b_re, ssm_b_im, ssm_c_re, ssm_c_im,
              ssm_d, ssm_w_glu, gmlp_norm_v, gmlp_w_s, gmlp_b_s,
              norm_ssm_out, norm_gmlp_out, w_out, norm_ffn2, w2_gate, w2_up, w2_down,
              norm_ple, w_ple_gate, w_ple_proj, norm_final):
    h = x
    for i in range(DEPTH):
        h = h + 0.5 * swiglu(rms_norm(h, norm_ffn1[i]), w1_gate[i], w1_up[i], w1_down[i])
        z = rms_norm(h, norm_mix[i]) @ w_in[i]
        z_ssm = z[..., :D_SSM]
        z_u = z[..., D_SSM:D_SSM + D_GMLP]
        z_v = z[..., D_SSM + D_GMLP:]
        y_ssm = s5_mixer(z_ssm, ssm_log_dt[i], ssm_a_re[i], ssm_a_im[i], ssm_b_re[i], ssm_b_im[i],
                         ssm_c_re[i], ssm_c_im[i], ssm_d[i], ssm_w_glu[i])
        y_gmlp = gmlp_mixer(z_u, z_v, gmlp_norm_v[i], gmlp_w_s[i], gmlp_b_s[i])
        y = jnp.concatenate([rms_norm(y_ssm, norm_ssm_out[i]), rms_norm(y_gmlp, norm_gmlp_out[i])], axis=-1)
        h = h + y @ w_out[i]
        h = h + 0.5 * swiglu(rms_norm(h, norm_ffn2[i]), w2_gate[i], w2_up[i], w2_down[i])
        gate = jax.nn.sigmoid(rms_norm(h, norm_ple[i]) @ w_ple_gate[i])
        h = h + gate * (p[i] @ w_ple_proj[i])
    return rms_norm(h, norm_final)
```

```cpp
#include <hip/hip_runtime.h>
#include <hip/hip_cooperative_groups.h>
#include <cstdio>
#include <cstdint>
namespace cg = cooperative_groups;
#define S5_FAST 1
#define ONE_LAUNCH 1
#define PG8_WGM 4
#define PG8_A_AUX 1
#define PG8_B_AUX 1
#ifndef PG8_WGM
#define PG8_WGM 8
#endif
namespace pg8 {
#define PG8_LAS __attribute__((address_space(3)))
typedef unsigned short bf16_t;
typedef short bf16x8 __attribute__((ext_vector_type(8)));
typedef float f32x4 __attribute__((ext_vector_type(4)));
typedef unsigned u32x4 __attribute__((ext_vector_type(4)));
constexpr int BM = 256, BK = 64, HALF = 128, HTB = HALF * BK * 2  , STAGE_BYTES = 8 * HTB, NXCD = 8, WGM = PG8_WGM;

__host__ __device__ __forceinline__ int lds_byte(int r, int c) { const int st = (r >> 4) * 2 + (c >> 5), rr = r & 15, cc = c & 31, ob = rr * 64 + cc * 2; return st * 1024 + (ob ^ (((ob >> 9) & 1) << 5)); }
__host__ __device__ __forceinline__ void stage_rc(int b, int& R, int& C) { const int st = b / 1024, sb = b % 1024, swz = sb ^ (((sb >> 9) & 1) << 5); R = (st >> 1) * 16 + swz / 64; C = (st & 1) * 32 + (swz % 64) / 2; }
__host__ __device__ __forceinline__ int perm32(int rho) { const int n = rho >> 4, i = rho & 15; return 8 * (i >> 2) + 4 * n + (i & 3); }

struct Unit { int pm, pn; };
struct Gemm { const bf16_t* A; const bf16_t* Bt; int M, N, K; };

struct StaticOrder {
    int nM, nN, nwg, G, c, wgm;
    __host__ __device__ void init(int M, int N, int G_, int c_, int wgm_ = PG8_WGM) { nM = M / BM; nN = N / BM; nwg = nM * nN; G = G_; c = c_; wgm = wgm_; }
    __host__ __device__ __forceinline__ bool next(int i, Unit& u) const {
        const long L = (long)i * G + c; if (L >= nwg) return false;
        int wgid = (int)L; { const int q = nwg / NXCD, r = nwg % NXCD, xcd = wgid % NXCD, off = wgid / NXCD; wgid = (xcd < r ? xcd * (q + 1) : r * (q + 1) + (xcd - r) * q) + off; }
        const int nig = wgm * nN, gid = wgid / nig, fm = gid * wgm, gsz = (nM - fm) < wgm ? (nM - fm) : wgm;
        u.pm = fm + ((wgid % nig) % gsz); u.pn = (wgid % nig) / gsz; return true;
    }
    __device__ __forceinline__ void a_ready(const Unit&) const {}
    __device__ __forceinline__ void done(const Unit&) const {}
};

__device__ __forceinline__ unsigned cvt_pk_bf16(float lo, float hi) { unsigned r; asm volatile("v_cvt_pk_bf16_f32 %0, %1, %2" : "=v"(r) : "v"(lo), "v"(hi)); return r; }
typedef float f32x2 __attribute__((ext_vector_type(2)));
constexpr float RMS_EPS = 1e-6f;
__device__ __forceinline__ float fast_sigmoid(float x) { return __builtin_amdgcn_rcpf(1.0f + __expf(-x)); }
__device__ __forceinline__ float gelu_tanh(float x) { const float u = x * (1.5957691216f + 0.0713548163f * x * x); return x * fast_sigmoid(u); }
__device__ __forceinline__ float bf_lo(unsigned w) { return __uint_as_float(w << 16); }
__device__ __forceinline__ float bf_hi(unsigned w) { return __uint_as_float(w & 0xffff0000u); }

template <int NP> __device__ __forceinline__ float row_total(const float* part, int row, int fq) {
    constexpr int PER = NP / 4;
    const float* p = part + (size_t)row * NP + fq * PER;
    float s;
    if constexpr (PER == 8) { const f32x4 a = *(const f32x4*)p, b = *(const f32x4*)(p + 4); s = ((a[0] + a[1]) + (a[2] + a[3])) + ((b[0] + b[1]) + (b[2] + b[3])); }
    else if constexpr (PER == 4) { const f32x4 a = *(const f32x4*)p; s = (a[0] + a[1]) + (a[2] + a[3]); }
    else { const f32x2 a = *(const f32x2*)p; s = a[0] + a[1]; }
    s += __shfl_xor(s, 16); s += __shfl_xor(s, 32);
    return s;
}

struct EpiSwiglu {
    static constexpr bool PERM = true, AFTER_DRAIN = false;
    bf16_t* O; const float* part; int ldo;
    __device__ __forceinline__ void operator()(const f32x4 (&acc)[2][2][4][2], const Unit& u, int wr, int wc, int fr, int fq) const {
        const int row0 = u.pm * BM + wr * 64 + fr, col0 = u.pn * 128 + wc * 32 + 8 * fq;
#ifndef EPI_SW_REPS
#define EPI_SW_REPS 1
#endif
#pragma unroll 1
        for (int rep_ = 0; rep_ < EPI_SW_REPS; ++rep_)
#pragma unroll
        for (int ai = 0; ai < 2; ++ai)
#pragma unroll
            for (int m = 0; m < 4; ++m) {
                const int row = row0 + ai * HALF + m * 16;
                const float r = rsqrtf(row_total<32>(part, row, fq) * (1.0f / 2048.0f) + RMS_EPS);
                f32x4 o0, o1;
#pragma unroll
                for (int j = 0; j < 4; ++j) { const float g = acc[ai][0][m][0][j] * r, up = acc[ai][1][m][0][j] * r; o0[j] = g * fast_sigmoid(g) * up; }
#pragma unroll
                for (int j = 0; j < 4; ++j) { const float g = acc[ai][0][m][1][j] * r, up = acc[ai][1][m][1][j] * r; o1[j] = g * fast_sigmoid(g) * up; }
                u32x4 w; w.x = cvt_pk_bf16(o0[0], o0[1]); w.y = cvt_pk_bf16(o0[2], o0[3]); w.z = cvt_pk_bf16(o1[0], o1[1]); w.w = cvt_pk_bf16(o1[2], o1[3]);
                *(u32x4*)(O + (size_t)row * ldo + col0) = w;
                asm volatile("" ::: "memory");
            }
    }
};

template <int NP> __device__ __forceinline__ void row_scales(const float* part, int row0, int fq, float inv_width, float (&sc)[8]) {
    constexpr int PER = NP / 4;
    float s[8];
    if constexpr (PER == 8) {
        f32x4 a[8], b[8];
#pragma unroll
        for (int i = 0; i < 8; ++i) { const float* p = part + (size_t)(row0 + (i >> 2) * HALF + (i & 3) * 16) * NP + fq * PER; a[i] = *(const f32x4*)p; b[i] = *(const f32x4*)(p + 4); }
#pragma unroll
        for (int i = 0; i < 8; ++i) s[i] = ((a[i][0] + a[i][1]) + (a[i][2] + a[i][3])) + ((b[i][0] + b[i][1]) + (b[i][2] + b[i][3]));
    } else if constexpr (PER == 4) {
        f32x4 a[8];
#pragma unroll
        for (int i = 0; i < 8; ++i) a[i] = *(const f32x4*)(part + (size_t)(row0 + (i >> 2) * HALF + (i & 3) * 16) * NP + fq * PER);
#pragma unroll
        for (int i = 0; i < 8; ++i) s[i] = (a[i][0] + a[i][1]) + (a[i][2] + a[i][3]);
    } else {
        f32x2 a[8];
#pragma unroll
        for (int i = 0; i < 8; ++i) a[i] = *(const f32x2*)(part + (size_t)(row0 + (i >> 2) * HALF + (i & 3) * 16) * NP + fq * PER);
#pragma unroll
        for (int i = 0; i < 8; ++i) s[i] = a[i][0] + a[i][1];
    }
#pragma unroll
    for (int i = 0; i < 8; ++i) { s[i] += __shfl_xor(s[i], 16); s[i] += __shfl_xor(s[i], 32); sc[i] = __builtin_amdgcn_rsqf(s[i] * inv_width + RMS_EPS); }
}

template <int SCALE_NP, bool GATE, bool WB, bool WP> struct EpiRes {
    static constexpr bool PERM = true, AFTER_DRAIN = false;
    const float* resid; float* out; bf16_t* hb; float* pout; const float* pin; const bf16_t* pp; float alpha; float inv_width;
    __device__ __forceinline__ void operator()(const f32x4 (&acc)[2][2][4][2], const Unit& u, int wr, int wc, int fr, int fq) const {
        const int row0 = u.pm * BM + wr * 64 + fr, col0 = u.pn * BM + wc * 32 + 8 * fq;
        float sc[8];
        if constexpr (SCALE_NP > 0) row_scales<SCALE_NP>(pin, row0, fq, inv_width, sc);
        f32x4 R[2][4]; u32x4 P[2][2];
#define EPIRES_LOAD(i, buf) { const size_t off_ = (size_t)(row0 + ((i) >> 2) * HALF + ((i) & 3) * 16) * 2048 + col0; \
            R[buf][0] = *(const f32x4*)(resid + off_); R[buf][1] = *(const f32x4*)(resid + off_ + 4); R[buf][2] = *(const f32x4*)(resid + off_ + HALF); R[buf][3] = *(const f32x4*)(resid + off_ + HALF + 4); \
            if constexpr (GATE) { P[buf][0] = *(const u32x4*)(pp + off_); P[buf][1] = *(const u32x4*)(pp + off_ + HALF); } }
        EPIRES_LOAD(0, 0)
#pragma unroll
        for (int i = 0; i < 8; ++i) {
            const int ai = i >> 2, m = i & 3, row = row0 + ai * HALF + m * 16, cb = i & 1;
            if (i < 7) EPIRES_LOAD(i + 1, cb ^ 1)
            const float scv = SCALE_NP > 0 ? sc[i] : alpha;
            float ss = 0.f;
#pragma unroll
            for (int bj = 0; bj < 2; ++bj) {
                const size_t off = (size_t)row * 2048 + col0 + bj * HALF;
                f32x4 a0 = acc[ai][bj][m][0] * scv, a1 = acc[ai][bj][m][1] * scv;
                if constexpr (GATE) {
                    const u32x4 pw = P[cb][bj];
                    a0[0] = fast_sigmoid(a0[0]) * bf_lo(pw.x); a0[1] = fast_sigmoid(a0[1]) * bf_hi(pw.x); a0[2] = fast_sigmoid(a0[2]) * bf_lo(pw.y); a0[3] = fast_sigmoid(a0[3]) * bf_hi(pw.y);
                    a1[0] = fast_sigmoid(a1[0]) * bf_lo(pw.z); a1[1] = fast_sigmoid(a1[1]) * bf_hi(pw.z); a1[2] = fast_sigmoid(a1[2]) * bf_lo(pw.w); a1[3] = fast_sigmoid(a1[3]) * bf_hi(pw.w);
                }
                const f32x4 o0 = R[cb][2 * bj] + a0, o1 = R[cb][2 * bj + 1] + a1;
                *(f32x4*)(out + off) = o0; *(f32x4*)(out + off + 4) = o1;
                if constexpr (WP) ss += ((o0[0] * o0[0] + o0[1] * o0[1]) + (o0[2] * o0[2] + o0[3] * o0[3])) + ((o1[0] * o1[0] + o1[1] * o1[1]) + (o1[2] * o1[2] + o1[3] * o1[3]));
                if constexpr (WB) { u32x4 w; w.x = cvt_pk_bf16(o0[0], o0[1]); w.y = cvt_pk_bf16(o0[2], o0[3]); w.z = cvt_pk_bf16(o1[0], o1[1]); w.w = cvt_pk_bf16(o1[2], o1[3]); *(u32x4*)(hb + off) = w; }
            }
            if constexpr (WP) { ss += __shfl_xor(ss, 16); ss += __shfl_xor(ss, 32); if (fq == 0) pout[(size_t)row * 32 + u.pn * 4 + wc] = ss; }
            asm volatile("" ::: "memory");
        }
#undef EPIRES_LOAD
    }
};

struct EpiWin {
    static constexpr bool PERM = true, AFTER_DRAIN = false;
    bf16_t* zs; size_t off_u, off_v; float* lnp; const float* part;
    __device__ __forceinline__ void operator()(const f32x4 (&acc)[2][2][4][2], const Unit& u, int wr, int wc, int fr, int fq) const {
        const int kind = u.pn >> 2, ct = u.pn & 3;
        const int row0 = u.pm * BM + wr * 64 + fr, col0 = ct * BM + wc * 32 + 8 * fq;
        bf16_t* dst = zs + (size_t)(kind == 1) * off_u + (size_t)(kind == 2) * off_v; const int ldd = 1024 << (kind == 1);
#pragma unroll
        for (int ai = 0; ai < 2; ++ai)
#pragma unroll
            for (int m = 0; m < 4; ++m) {
                const int row = row0 + ai * HALF + m * 16;
                const float r = rsqrtf(row_total<32>(part, row, fq) * (1.0f / 2048.0f) + RMS_EPS);
                float s1 = 0.f, s2 = 0.f;
#pragma unroll
                for (int bj = 0; bj < 2; ++bj) {
                    f32x4 o0 = acc[ai][bj][m][0] * r, o1 = acc[ai][bj][m][1] * r;
                    if (kind != 0) {
#pragma unroll
                        for (int j = 0; j < 4; ++j) { o0[j] = gelu_tanh(o0[j]); o1[j] = gelu_tanh(o1[j]); } }
                    s1 += ((o0[0] + o0[1]) + (o0[2] + o0[3])) + ((o1[0] + o1[1]) + (o1[2] + o1[3]));
                    s2 += ((o0[0] * o0[0] + o0[1] * o0[1]) + (o0[2] * o0[2] + o0[3] * o0[3])) + ((o1[0] * o1[0] + o1[1] * o1[1]) + (o1[2] * o1[2] + o1[3] * o1[3]));
                    u32x4 w; w.x = cvt_pk_bf16(o0[0], o0[1]); w.y = cvt_pk_bf16(o0[2], o0[3]); w.z = cvt_pk_bf16(o1[0], o1[1]); w.w = cvt_pk_bf16(o1[2], o1[3]);
                    *(u32x4*)(dst + (size_t)row * ldd + col0 + bj * HALF) = w;
                }
                if (kind == 2) {
                    s1 += __shfl_xor(s1, 16); s1 += __shfl_xor(s1, 32); s2 += __shfl_xor(s2, 16); s2 += __shfl_xor(s2, 32);
                    if (fq == 0) *(f32x2*)(lnp + ((size_t)row * 16 + ct * 4 + wc) * 2) = (f32x2){s1, s2};
                }
                asm volatile("" ::: "memory");
            }
    }
};

struct EpiGlu {
    static constexpr bool PERM = true, AFTER_DRAIN = false;
    const bf16_t* yg; bf16_t* ys; float* ssp;
    __device__ __forceinline__ void operator()(const f32x4 (&acc)[2][2][4][2], const Unit& u, int wr, int wc, int fr, int fq) const {
        const int row0 = u.pm * BM + wr * 64 + fr, col0 = u.pn * BM + wc * 32 + 8 * fq;
#pragma unroll
        for (int ai = 0; ai < 2; ++ai)
#pragma unroll
            for (int m = 0; m < 4; ++m) {
                const int row = row0 + ai * HALF + m * 16;
                float ss = 0.f;
#pragma unroll
                for (int bj = 0; bj < 2; ++bj) {
                    const size_t off = (size_t)row * 1024 + col0 + bj * HALF, offo = (size_t)row * 2048 + col0 + bj * HALF;
                    const u32x4 yw = *(const u32x4*)(yg + off);
                    float o[8];
                    o[0] = bf_lo(yw.x) * fast_sigmoid(acc[ai][bj][m][0][0]); o[1] = bf_hi(yw.x) * fast_sigmoid(acc[ai][bj][m][0][1]);
                    o[2] = bf_lo(yw.y) * fast_sigmoid(acc[ai][bj][m][0][2]); o[3] = bf_hi(yw.y) * fast_sigmoid(acc[ai][bj][m][0][3]);
                    o[4] = bf_lo(yw.z) * fast_sigmoid(acc[ai][bj][m][1][0]); o[5] = bf_hi(yw.z) * fast_sigmoid(acc[ai][bj][m][1][1]);
                    o[6] = bf_lo(yw.w) * fast_sigmoid(acc[ai][bj][m][1][2]); o[7] = bf_hi(yw.w) * fast_sigmoid(acc[ai][bj][m][1][3]);
#pragma unroll
                    for (int e = 0; e < 8; ++e) ss += o[e] * o[e];
                    u32x4 w; w.x = cvt_pk_bf16(o[0], o[1]); w.y = cvt_pk_bf16(o[2], o[3]); w.z = cvt_pk_bf16(o[4], o[5]); w.w = cvt_pk_bf16(o[6], o[7]);
                    *(u32x4*)(ys + offo) = w;
                }
                ss += __shfl_xor(ss, 16); ss += __shfl_xor(ss, 32);
                if (fq == 0) ssp[(size_t)row * 16 + u.pn * 4 + wc] = ss;
            }
    }
};

struct EpiPlain {
    static constexpr bool PERM = true, AFTER_DRAIN = false;
    bf16_t* O; int ldo;
    __device__ __forceinline__ void operator()(const f32x4 (&acc)[2][2][4][2], const Unit& u, int wr, int wc, int fr, int fq) const {
        const int row0 = u.pm * BM + wr * 64 + fr, col0 = u.pn * BM + wc * 32 + 8 * fq;
#pragma unroll
        for (int ai = 0; ai < 2; ++ai)
#pragma unroll
            for (int m = 0; m < 4; ++m)
#pragma unroll
                for (int bj = 0; bj < 2; ++bj) {
                    const f32x4 v0 = acc[ai][bj][m][0], v1 = acc[ai][bj][m][1];
                    u32x4 w; w.x = cvt_pk_bf16(v0[0], v0[1]); w.y = cvt_pk_bf16(v0[2], v0[3]); w.z = cvt_pk_bf16(v1[0], v1[1]); w.w = cvt_pk_bf16(v1[2], v1[3]);
                    *(u32x4*)(O + (size_t)(row0 + ai * HALF + m * 16) * ldo + col0 + bj * HALF) = w;
                }
    }
};
template <class Epi, class Sched, bool ALIGN_EPI = false, bool SP2 = false, bool MID = false>
__device__ __forceinline__ void gemm_phase(PG8_LAS unsigned char* lds, const Gemm g, const Sched& S, const Epi& E, const PG8_LAS float* midtab = nullptr) {
    int tid = threadIdx.x; asm volatile("" : "+v"(tid));
    const int wid = __builtin_amdgcn_readfirstlane(tid >> 6), lane = tid & 63, wr = wid >> 2, wc = wid & 3, fr = lane & 15, fq = lane >> 4;
    int K = g.K; asm volatile("" : "+s"(K));     const int nt = K / BK;
    unsigned voffA[2], voffB[2];
#pragma unroll
    for (int i = 0; i < 2; ++i) { int R, C; stage_rc(tid * 16 + i * 8192, R, C); const int Rb = Epi::PERM ? ((R & ~31) + perm32(R & 31)) : R;
        voffA[i] = (unsigned)(R * K + C) * 2u; voffB[i] = (unsigned)(Rb * K + C) * 2u; }
    const size_t kstep = (size_t)(BK * 2);
    const size_t hstep = (size_t)HALF * K * 2;
    const size_t tstep = 2 * hstep;
    const unsigned ldsw = (unsigned)wid * 1024u;
    const int aoff = lds_byte(wr * 64 + fr, fq * 8), boff = lds_byte(wc * 32 + fr, fq * 8);
#define PG8_SA(b, h) (((b) * 2 + (h)) * HTB)
#define PG8_SB(b, h) ((4 + (b) * 2 + (h)) * HTB)
#ifndef PG8_A_AUX
#define PG8_A_AUX 0
#endif
#ifndef PG8_B_AUX
#define PG8_B_AUX 0
#endif
#define PG8_AUX_voffA PG8_A_AUX
#define PG8_AUX_voffB PG8_B_AUX
#define PG8_STAGE(bufoff, gbase, voff) do { _Pragma("unroll") for (int _i = 0; _i < 2; ++_i) \
        __builtin_amdgcn_global_load_lds((const unsigned*)((const char*)(gbase) + (voff)[_i]), (PG8_LAS unsigned*)(lds + (bufoff) + ldsw + _i * 8192), 16, 0, PG8_AUX_##voff); } while (0)
#define PG8_LDA(dst, b, h) do { _Pragma("unroll") for (int m = 0; m < 4; ++m) _Pragma("unroll") for (int k = 0; k < 2; ++k) dst[m][k] = *(const PG8_LAS bf16x8*)(lds + PG8_SA(b, h) + aoff + m * 2048 + k * 1024); } while (0)
#define PG8_LDB(dst, b, h) do { _Pragma("unroll") for (int n = 0; n < 2; ++n) _Pragma("unroll") for (int k = 0; k < 2; ++k) dst[n][k] = *(const PG8_LAS bf16x8*)(lds + PG8_SB(b, h) + boff + n * 2048 + k * 1024); } while (0)
#define PG8_MMA(ai, bj, At, Bt) do { __builtin_amdgcn_s_setprio(1); _Pragma("unroll") for (int m = 0; m < 4; ++m) _Pragma("unroll") for (int n = 0; n < 2; ++n) _Pragma("unroll") for (int k = 0; k < 2; ++k) \
        acc[ai][bj][m][n] = __builtin_amdgcn_mfma_f32_16x16x32_bf16(Bt[n][k], At[m][k], acc[ai][bj][m][n], 0, 0, 0); __builtin_amdgcn_s_setprio(0); } while (0)
#define PG8_WAIT_V(n) asm volatile("s_waitcnt vmcnt(" #n ")" ::: "memory")
#define PG8_WAIT_L(n) asm volatile("s_waitcnt lgkmcnt(" #n ")" ::: "memory")
#define PG8_BAR __builtin_amdgcn_s_barrier()
#define PG8_SCHED __builtin_amdgcn_sched_barrier(0)
    Unit cur, nxt; int ui = 0;
    if (!S.next(0, cur)) return;
    f32x4 acc[2][2][4][2];
#pragma unroll
    for (int a = 0; a < 2; ++a)
#pragma unroll
        for (int b = 0; b < 2; ++b)
#pragma unroll
            for (int m = 0; m < 4; ++m)
#pragma unroll
                for (int n = 0; n < 2; ++n) acc[a][b][m][n] = (f32x4){0.f, 0.f, 0.f, 0.f};
    bf16x8 At[4][2], B0[2][2], B1[2][2];
    const char* cA = (const char*)g.A + (size_t)cur.pm * tstep; const char* cB = (const char*)g.Bt + (size_t)cur.pn * tstep;
    S.a_ready(cur);
    if constexpr (SP2) {
        PG8_STAGE(PG8_SB(0, 0), cB, voffB); PG8_STAGE(PG8_SB(0, 1), cB + hstep, voffB); PG8_STAGE(PG8_SA(0, 0), cA, voffA); PG8_STAGE(PG8_SA(0, 1), cA + hstep, voffA);
        if (wr == 1) PG8_BAR;
        PG8_WAIT_V(2); PG8_BAR;
        PG8_STAGE(PG8_SB(1, 0), cB + kstep, voffB); PG8_STAGE(PG8_SA(1, 0), cA + kstep, voffA); PG8_STAGE(PG8_SB(1, 1), cB + hstep + kstep, voffB);
        PG8_WAIT_V(6); PG8_BAR;
    } else {
        PG8_STAGE(PG8_SB(0, 0), cB, voffB); PG8_STAGE(PG8_SA(0, 0), cA, voffA); PG8_STAGE(PG8_SB(0, 1), cB + hstep, voffB); PG8_STAGE(PG8_SA(0, 1), cA + hstep, voffA);
        if (wr == 1) PG8_BAR;
        PG8_WAIT_V(4); PG8_BAR;
        PG8_STAGE(PG8_SB(1, 0), cB + kstep, voffB); PG8_STAGE(PG8_SA(1, 0), cA + kstep, voffA); PG8_STAGE(PG8_SB(1, 1), cB + hstep + kstep, voffB);
        PG8_WAIT_V(6); PG8_BAR;
    }
    for (;;) {
        const bool has_next = S.next(ui + 1, nxt);
        const char* nA = has_next ? (const char*)g.A + (size_t)nxt.pm * tstep : cA; const char* nB = has_next ? (const char*)g.Bt + (size_t)nxt.pn * tstep : cB;
        for (int t = 0; t < nt; t += 2) {
            const bool last = (t == nt - 2);
            const char* a1 = cA + (size_t)(t + 1) * kstep;
            const char* a2 = last ? nA : cA + (size_t)(t + 2) * kstep; const char* b2 = last ? nB : cB + (size_t)(t + 2) * kstep;
            const char* a3 = a2 + kstep; const char* b3 = b2 + kstep;
            if (last && has_next) S.a_ready(nxt);
            if constexpr (MID) { if (t == (nt >> 1)) {
#pragma unroll
                for (int ai = 0; ai < 2; ++ai)
#pragma unroll
                    for (int m = 0; m < 4; ++m) { const float f = midtab[(ui & 7) * 256 + ai * HALF + wr * 64 + m * 16 + fr];
#pragma unroll
                        for (int bj = 0; bj < 2; ++bj)
#pragma unroll
                            for (int n = 0; n < 2; ++n) acc[ai][bj][m][n] *= f; } } }
            if constexpr (SP2) {
            PG8_LDB(B0, 0, 0); PG8_LDB(B1, 0, 1); PG8_SCHED; PG8_LDA(At, 0, 0); PG8_STAGE(PG8_SA(1, 1), a1 + hstep, voffA);
            PG8_WAIT_V(8); PG8_WAIT_L(0); PG8_BAR; PG8_MMA(0, 0, At, B0); PG8_MMA(0, 1, At, B1); PG8_BAR; PG8_SCHED;
            PG8_LDA(At, 0, 1); PG8_STAGE(PG8_SB(0, 0), b2, voffB); PG8_STAGE(PG8_SB(0, 1), b2 + hstep, voffB); PG8_STAGE(PG8_SA(0, 0), a2, voffA);
            PG8_WAIT_V(8); PG8_WAIT_L(0); PG8_BAR; PG8_MMA(1, 0, At, B0); PG8_MMA(1, 1, At, B1); PG8_BAR; PG8_SCHED;
            PG8_LDB(B0, 1, 0); PG8_LDB(B1, 1, 1); PG8_SCHED; PG8_LDA(At, 1, 0); PG8_STAGE(PG8_SA(0, 1), a2 + hstep, voffA);
            PG8_WAIT_V(8); PG8_WAIT_L(0); PG8_BAR; PG8_MMA(0, 0, At, B0); PG8_MMA(0, 1, At, B1); PG8_BAR; PG8_SCHED;
            PG8_LDA(At, 1, 1); PG8_STAGE(PG8_SB(1, 0), b3, voffB); PG8_STAGE(PG8_SB(1, 1), b3 + hstep, voffB); PG8_STAGE(PG8_SA(1, 0), a3, voffA);
            PG8_WAIT_V(8); PG8_WAIT_L(0); PG8_BAR; PG8_MMA(1, 0, At, B0); PG8_MMA(1, 1, At, B1); PG8_BAR; PG8_SCHED;
            } else {
            PG8_LDB(B0, 0, 0); PG8_SCHED; PG8_LDA(At, 0, 0); PG8_STAGE(PG8_SA(1, 1), a1 + hstep, voffA);
            PG8_WAIT_L(8); PG8_BAR; PG8_WAIT_L(0); PG8_MMA(0, 0, At, B0); PG8_BAR; PG8_SCHED;
            PG8_LDB(B1, 0, 1); PG8_STAGE(PG8_SB(0, 0), b2, voffB);
            PG8_BAR; PG8_WAIT_L(0); PG8_MMA(0, 1, At, B1); PG8_BAR;
            PG8_LDA(At, 0, 1); PG8_STAGE(PG8_SA(0, 0), a2, voffA);
            PG8_BAR; PG8_WAIT_L(0); PG8_MMA(1, 0, At, B0); PG8_BAR; PG8_SCHED;
            PG8_STAGE(PG8_SB(0, 1), b2 + hstep, voffB);
            PG8_WAIT_V(6); PG8_BAR; PG8_MMA(1, 1, At, B1); PG8_BAR;
            PG8_LDB(B0, 1, 0); PG8_SCHED; PG8_LDA(At, 1, 0); PG8_STAGE(PG8_SA(0, 1), a2 + hstep, voffA);
            PG8_WAIT_L(8); PG8_BAR; PG8_WAIT_L(0); PG8_MMA(0, 0, At, B0); PG8_BAR; PG8_SCHED;
            PG8_LDB(B1, 1, 1); PG8_STAGE(PG8_SB(1, 0), b3, voffB);
            PG8_BAR; PG8_WAIT_L(0); PG8_MMA(0, 1, At, B1); PG8_BAR;
            PG8_LDA(At, 1, 1); PG8_STAGE(PG8_SA(1, 0), a3, voffA);
            PG8_BAR; PG8_WAIT_L(0); PG8_MMA(1, 0, At, B0); PG8_BAR; PG8_SCHED;
            PG8_STAGE(PG8_SB(1, 1), b3 + hstep, voffB);
            PG8_WAIT_V(6); PG8_BAR; PG8_MMA(1, 1, At, B1); PG8_BAR;
            }
        }
        if constexpr (ALIGN_EPI) { if (wr == 0) PG8_BAR; }
        if constexpr (!Epi::AFTER_DRAIN) { E(acc, cur, wr, wc, fr, fq); S.done(cur); }
        if (!has_next) break;
#pragma unroll
        for (int a = 0; a < 2; ++a)
#pragma unroll
            for (int b = 0; b < 2; ++b)
#pragma unroll
                for (int m = 0; m < 4; ++m)
#pragma unroll
                    for (int n = 0; n < 2; ++n) acc[a][b][m][n] = (f32x4){0.f, 0.f, 0.f, 0.f};
        cur = nxt; cA = nA; cB = nB; ++ui;
        if constexpr (ALIGN_EPI) { if (wr == 1) PG8_BAR; }
    }
    PG8_WAIT_V(0);
    if constexpr (!ALIGN_EPI) { if (wr == 0) PG8_BAR; }
    PG8_BAR;
    if constexpr (Epi::AFTER_DRAIN) { E.fused(acc, cur, wr, wc, fr, fq, lds, wid, lane); S.done(cur); }
#undef PG8_SA
#undef PG8_SB
#undef PG8_STAGE
#undef PG8_LDA
#undef PG8_LDB
#undef PG8_MMA
#undef PG8_WAIT_V
#undef PG8_WAIT_L
#undef PG8_BAR
#undef PG8_SCHED
}
}
#define LAS __attribute__((address_space(3)))
#define GAS __attribute__((address_space(1)))
typedef unsigned short bf16;
typedef unsigned v4u __attribute__((ext_vector_type(4)));
typedef unsigned v2u __attribute__((ext_vector_type(2)));
typedef float f32x4 __attribute__((ext_vector_type(4)));
typedef float f32x2 __attribute__((ext_vector_type(2)));
typedef short bf16x8 __attribute__((ext_vector_type(8)));
#define LDS_WAIT() asm volatile("s_waitcnt lgkmcnt(0)" ::: "memory")

#define XB_TMO      128
#define XB_XCNT(j)  (256  + 64 * (j))
#define XB_XSUB(j)  (1280 + 64 * (j))
#define XB_XGEN(j)  (2304 + 64 * (j))
#define XB_TOP      3328
#define XB_TOPGEN   3392
#define XCD_BAR_WORDS 3456
#define XB_SPIN_CAP (1u << 18)

__device__ __forceinline__ unsigned xb_ld(unsigned* p)              { return __hip_atomic_load(p, __ATOMIC_RELAXED, __HIP_MEMORY_SCOPE_AGENT); }
__device__ __forceinline__ unsigned xb_add(unsigned* p, unsigned v) { return __hip_atomic_fetch_add(p, v, __ATOMIC_RELAXED, __HIP_MEMORY_SCOPE_AGENT); }
__device__ __forceinline__ unsigned xb_xcc_id() { return (unsigned)__builtin_amdgcn_s_getreg((3 << 11) | 20) & 0xFu; }
#define XB_SPIN(cond, bar) do { unsigned _sp = 0; while (cond) { __builtin_amdgcn_s_sleep(1); \
    if ((++_sp & 255u) == 0u) { if (xb_ld(&(bar)[XB_TMO])) break; if (_sp > XB_SPIN_CAP) { atomicAdd(&(bar)[XB_TMO], 1u); break; } } } } while (0)

struct XcdBarrier {
    unsigned* bar; unsigned x;
    volatile LAS unsigned* st;
};

__device__ __forceinline__ XcdBarrier xcd_barrier_post(unsigned* bar, volatile LAS unsigned* st) {
    XcdBarrier b; b.bar = bar; b.x = xb_xcc_id(); b.st = st;
    if (threadIdx.x == 0) st[2] = xb_add(&bar[XB_XCNT(b.x)], 1u);
    return b;
}
__device__ __forceinline__ void xcd_barrier_complete(unsigned* bar, unsigned x, unsigned& nloc, unsigned& nx) {
    const unsigned G = gridDim.x * gridDim.y * gridDim.z;
    unsigned sum, cnt, mine, sp = 0u;
    for (;;) {
        sum = 0u; cnt = 0u; mine = 0u;
#pragma unroll
        for (unsigned j = 0; j < 16; ++j) { const unsigned c = xb_ld(&bar[XB_XCNT(j)]); sum += c; cnt += (c > 0u) ? 1u : 0u; mine = (j == x) ? c : mine; }
        if (sum == G) break;
        __builtin_amdgcn_s_sleep(1);
        if ((++sp & 255u) == 0u) { if (xb_ld(&bar[XB_TMO])) break; if (sp > XB_SPIN_CAP) { atomicAdd(&bar[XB_TMO], 1u); break; } }
    }
    nloc = mine > 0u ? mine : 1u; nx = cnt > 0u ? cnt : 1u;
}

__device__ __forceinline__ void xcd_barrier(const XcdBarrier& b) {
    asm volatile("s_waitcnt vmcnt(0)" ::: "memory");
    __syncthreads();
    if (threadIdx.x == 0) {
        unsigned* bar = b.bar;
        __builtin_amdgcn_s_waitcnt(0);
        unsigned nloc = b.st[0], nx = b.st[1];
        if (nloc == 0u) { xcd_barrier_complete(bar, b.x, nloc, nx); b.st[0] = nloc; b.st[1] = nx; }
        const unsigned old = xb_add(&bar[XB_XSUB(b.x)], 1u);
        const unsigned gen = old / nloc;
        if (old + 1u == (gen + 1u) * nloc) {
            __builtin_amdgcn_fence(__ATOMIC_RELEASE, "agent");
            asm volatile("s_waitcnt vmcnt(0)" ::: "memory");
            const unsigned og = xb_add(&bar[XB_TOP], 1u);
            const unsigned tg = og / nx;
            if (og + 1u == (tg + 1u) * nx) xb_add(&bar[XB_TOPGEN], 1u);
            else XB_SPIN(xb_ld(&bar[XB_TOPGEN]) == tg, bar);
            __builtin_amdgcn_fence(__ATOMIC_ACQUIRE, "agent");
            xb_add(&bar[XB_XGEN(b.x)], 1u);
            asm volatile("s_waitcnt vmcnt(0)" ::: "memory");
        } else {
            XB_SPIN(xb_ld(&bar[XB_XGEN(b.x)]) == gen, bar);
            __builtin_amdgcn_fence(__ATOMIC_ACQUIRE, "agent");
            asm volatile("s_waitcnt vmcnt(0)" ::: "memory");
        }
    }
    __syncthreads();
}

__device__ __forceinline__ void xcd_local_barrier(const XcdBarrier& b) {
    asm volatile("s_waitcnt vmcnt(0)" ::: "memory");
    __syncthreads();
    if (threadIdx.x == 0) {
        unsigned* bar = b.bar;
        __builtin_amdgcn_s_waitcnt(0);
        const unsigned nloc = b.st[0];
        const unsigned old = xb_add(&bar[XB_XSUB(b.x)], 1u);
        const unsigned gen = old / nloc;
        if (old + 1u == (gen + 1u) * nloc) xb_add(&bar[XB_XGEN(b.x)], 1u);
        else XB_SPIN(xb_ld(&bar[XB_XGEN(b.x)]) == gen, bar);
        __builtin_amdgcn_fence(__ATOMIC_ACQUIRE, "agent");
        asm volatile("s_waitcnt vmcnt(0)" ::: "memory");
    }
    __syncthreads();
}


#ifndef WGM_UP
#define WGM_UP PG8_WGM
#endif
#ifndef WGM_DN
#define WGM_DN PG8_WGM
#endif
#ifndef GP_ALIGN
#define GP_ALIGN true
#endif
#ifndef GP_SP2
#define GP_SP2 true
#endif
#ifndef S5_FAST
#define S5_FAST 1
#endif
#ifndef ONE_LAUNCH
#define ONE_LAUNCH 1
#endif

constexpr int NWAVES = 8;
constexpr int M = 16384, D = 2048, FF = 5632, DSSM = 1024, DG = 1024, DIN = 3072, DPLE = 256, SEQ = 4096;
constexpr float EPS = 1e-6f;
constexpr size_t MiB = 1u << 20;
constexpr size_t WS_W1GU = 1 * MiB, WS_W1D = 45 * MiB, WS_WIN = 67 * MiB, WS_WGLU = 79 * MiB, WS_WO = 81 * MiB, WS_W2GU = 89 * MiB, WS_W2D = 133 * MiB,
                 WS_WPG = 155 * MiB, WS_WPP = 163 * MiB, WS_S5W1 = 164 * MiB, WS_S5W3 = 168 * MiB, WS_S5C = 180 * MiB, WS_HPA = 181 * MiB, WS_HPB = 183 * MiB, WS_LNP = 185 * MiB,
                 WS_SSP = 187 * MiB, WS_GSP = 188 * MiB, WS_PB = 189 * MiB, WS_HB = 197 * MiB, WS_ACT = 261 * MiB, WS_ZS = 261 * MiB, WS_GV = 293 * MiB,
                 WS_YG = 325 * MiB, WS_YCAT = 357 * MiB  , WS_PP = 437 * MiB, WS_END = 501 * MiB;
constexpr int RING_BYTES = 131072, LDS_BYTES = 163840, MISC_OFF = LDS_BYTES - 256;
constexpr int S5_IMG_BYTES = 144 * 1024;

__device__ __forceinline__ unsigned f2bf(float f) { unsigned u = __builtin_bit_cast(unsigned, f); return (u + 0x7fffu + ((u >> 16) & 1u)) >> 16; }
__device__ __forceinline__ unsigned pk2(float lo, float hi) { return f2bf(lo) | (f2bf(hi) << 16); }
__device__ __forceinline__ float bflo(unsigned w) { return __uint_as_float(w << 16); }
__device__ __forceinline__ float bfhi(unsigned w) { return __uint_as_float(w & 0xffff0000u); }
__device__ __forceinline__ float wave_sum(float v) {
#pragma unroll
    for (int o = 1; o < 64; o <<= 1) v += __shfl_xor(v, o);
    return v;
}

struct Args { const float* in[31]; float* out; unsigned char* ws; int ph_lo, ph_hi; };
#define KARG_PTR(T, i) (((T const volatile __attribute__((address_space(4)))*)__builtin_amdgcn_kernarg_segment_ptr())[i])
#define INP(i) KARG_PTR(const float*, i)
#define OUTP() KARG_PTR(float*, 31)
#define WSP() KARG_PTR(unsigned char*, 32)
#define KARG_INT(i) KARG_PTR(int, i)
static_assert(sizeof(Args) == 33 * 8 + 8, "Args has no padding");

__device__ __forceinline__ void p0_transpose_item(const float* W, int K, int N, bf16* WT, const float* gain, int map, LAS float* scr, int item, int lane, int ldk = 0) {
    if (ldk == 0) ldk = K;
    const int nblk = N / 32, kb = item / nblk, nb = item % nblk, k0 = 64 * kb, n0 = 32 * nb;
#pragma unroll 8
    for (int i = 0; i < 32; ++i) { const int kk = 2 * i + (lane >> 5); scr[kk * 33 + (lane & 31)] = W[(size_t)(k0 + kk) * N + n0 + (lane & 31)]; }
    LDS_WAIT(); asm volatile("" ::: "memory");
    const int c = lane & 7;
    float gk[8];
#pragma unroll
    for (int e = 0; e < 8; ++e) gk[e] = gain ? gain[k0 + 8 * c + e] : 1.0f;
#pragma unroll
    for (int j = 0; j < 4; ++j) { const int nl = (lane >> 3) + 8 * j; const int n = n0 + nl; const LAS float* s = scr + (8 * c) * 33 + nl;
        const int drow = map == 0 ? n : (256 * (n >> 7) + (n & 127) + (map == 2 ? 128 : 0));
        v4u o; o.x = pk2(s[0 * 33] * gk[0], s[1 * 33] * gk[1]); o.y = pk2(s[2 * 33] * gk[2], s[3 * 33] * gk[3]); o.z = pk2(s[4 * 33] * gk[4], s[5 * 33] * gk[5]); o.w = pk2(s[6 * 33] * gk[6], s[7 * 33] * gk[7]);
        *(v4u*)(WT + (size_t)drow * ldk + k0 + 8 * c) = o; }
    LDS_WAIT(); asm volatile("" ::: "memory");
}

__device__ __forceinline__ void s5_gen(const Args& a, int g, LAS float* L, int tid) {
    LAS float* Pr = L; LAS float* Pi = L + 21 * 64; LAS float* Bbr = L + 42 * 64; LAS float* Bbi = Bbr + 1024; LAS float* Kd = Bbi + 1024;
    const float* log_dt = INP(8); const float* a_re = INP(9); const float* a_im = INP(10); const float* b_re = INP(11); const float* b_im = INP(12);
    const float* c_re = INP(13); const float* c_im = INP(14); const float* dvec = INP(15);
    bf16* W1 = (bf16*)(WSP() + WS_S5W1 + (size_t)g * S5_IMG_BYTES); bf16* W3C = W1 + 64 * 512; bf16* W3T = W1 + 128 * 512; float* SC = (float*)(WSP() + WS_S5C) + (size_t)g * 640;
    LAS float* Cr = Kd + 4096; LAS float* Ci = Cr + 1024; LAS float* Zr = Ci + 1024; LAS float* Zi = Zr + 64;
    const double dt = exp((double)log_dt[g]);
    for (int idx = tid; idx < 21 * 64; idx += 512) {
        const int n = idx & 63, k = idx >> 6;
        const double lr = fmin((double)a_re[g * 64 + n], -1e-4), li = (double)a_im[g * 64 + n];
        const double kk = k <= 16 ? (double)k : (k == 17 ? 32.0 : (k == 18 ? 64.0 : (k == 19 ? 128.0 : 512.0)));
        const double mag = exp(lr * dt * kk), ang = li * dt * kk;
        Pr[k * 64 + n] = (float)(mag * cos(ang)); Pi[k * 64 + n] = (float)(mag * sin(ang));
    }
    if (tid < 64) {
        const int n = tid;
        const double lr = fmin((double)a_re[g * 64 + n], -1e-4), li = (double)a_im[g * 64 + n];
        const double mag = exp(lr * dt), ang = li * dt, abr = mag * cos(ang), abi = mag * sin(ang);
        const double xr = abr - 1.0, xi = abi, den = lr * lr + li * li;
        Zr[n] = (float)((xr * lr + xi * li) / den); Zi[n] = (float)((xi * lr - xr * li) / den);
    }
    for (int idx = tid; idx < 1024; idx += 512) { Cr[idx] = c_re[g * 1024 + idx]; Ci[idx] = c_im[g * 1024 + idx]; }
    __syncthreads();
    for (int idx = tid; idx < 1024; idx += 512) { const int n = idx >> 4; const float br = b_re[g * 1024 + idx], bi = b_im[g * 1024 + idx], zr = Zr[n], zi = Zi[n];
        Bbr[idx] = zr * br - zi * bi; Bbi[idx] = zr * bi + zi * br; }
    for (int idx = tid; idx < 640; idx += 512) { const int l = idx >> 7, ri = (idx >> 6) & 1, n = idx & 63, k = l == 0 ? 16 : 16 + l; SC[idx] = ri ? Pi[k * 64 + n] : Pr[k * 64 + n]; }
    __syncthreads();
    for (int idx = tid; idx < 4096; idx += 512) {
        const int d = idx >> 8, p = (idx >> 4) & 15, pq = idx & 15; float s = 0.f;
        for (int n = 0; n < 64; ++n) { const float pr = Pr[d * 64 + n], pi = Pi[d * 64 + n], br = Bbr[n * 16 + pq], bi = Bbi[n * 16 + pq];
            const float xr = pr * br - pi * bi, xi = pr * bi + pi * br; s += Cr[p * 64 + n] * xr - Ci[p * 64 + n] * xi; }
        Kd[idx] = s;
    }
    __syncthreads();
    for (int id = tid; id < 64 * 64; id += 512) {
        const int f = id >> 6, lane = id & 63, mt = f >> 3, ks = f & 7, q = lane >> 4, r = lane & 15, np = 16 * mt + r, n = np & 63, s = 2 * ks + (q >> 1);
        const float pr = Pr[(15 - s) * 64 + n], pi = Pi[(15 - s) * 64 + n]; float v[8];
#pragma unroll
        for (int e = 0; e < 8; ++e) { const int p = 8 * (q & 1) + e; const float br = Bbr[n * 16 + p], bi = Bbi[n * 16 + p]; v[e] = np < 64 ? (pr * br - pi * bi) : (pr * bi + pi * br); }
        v4u o; o.x = pk2(v[0], v[1]); o.y = pk2(v[2], v[3]); o.z = pk2(v[4], v[5]); o.w = pk2(v[6], v[7]);
        *(v4u*)(W1 + (size_t)id * 8) = o;
    }
    for (int id = tid; id < 64 * 64; id += 512) {
        const int f = id >> 6, lane = id & 63, t = f >> 2, ks = f & 3, q = lane >> 4, p = lane & 15; float v[8];
#pragma unroll
        for (int e = 0; e < 8; ++e) { const int mtp = 2 * ks + (e >> 2), j = e & 3, n = 16 * (mtp & 3) + 4 * q + j;
            const float cr = Cr[p * 64 + n], ci = Ci[p * 64 + n], pr = Pr[(t + 1) * 64 + n], pi = Pi[(t + 1) * 64 + n];
            v[e] = mtp < 4 ? (cr * pr - ci * pi) : -(cr * pi + ci * pr); }
        v4u o; o.x = pk2(v[0], v[1]); o.y = pk2(v[2], v[3]); o.z = pk2(v[4], v[5]); o.w = pk2(v[6], v[7]);
        *(v4u*)(W3C + (size_t)id * 8) = o;
    }
    for (int id = tid; id < 16 * 64; id += 512) {
        const int dl = id >> 6, lane = id & 63, q = lane >> 4, p = lane & 15, lag = dl - (q >> 1); float v[8];
#pragma unroll
        for (int e = 0; e < 8; ++e) { const int pq = 8 * (q & 1) + e; float x = 0.f; if (lag >= 0) x = Kd[(lag * 16 + p) * 16 + pq]; if (lag == 0 && pq == p) x += dvec[g * 16 + p]; v[e] = x; }
        v4u o; o.x = pk2(v[0], v[1]); o.y = pk2(v[2], v[3]); o.z = pk2(v[4], v[5]); o.w = pk2(v[6], v[7]);
        *(v4u*)(W3T + (size_t)id * 8) = o;
    }
    __syncthreads();
}

__device__ __forceinline__ void p0_prologue(const Args& a, LAS unsigned char* lds, int tid, int lane, int wave, int G) {
#ifndef S5GEN_REPS
#define S5GEN_REPS 1
#endif
    for (int rr = 0; rr < S5GEN_REPS; ++rr)
    for (int g = blockIdx.x; g < 64; g += G) s5_gen(a, g, (LAS float*)lds, tid);
    __syncthreads();
    LAS float* scr = (LAS float*)(lds + wave * 16384);
    const int gw = blockIdx.x * NWAVES + wave, NGW = G * NWAVES;
    unsigned char* ws = WSP();
    constexpr int I_GU = (D / 64) * (FF / 32), I_DN = (FF / 64) * (D / 32), I_IN = (D / 64) * (DIN / 32), I_GLU = (DSSM / 64) * (DSSM / 32), I_OH = (1024 / 64) * (D / 32), I_PG = (D / 64) * (D / 32), I_PP = (DPLE / 64) * (D / 32);
    constexpr int NITEMS = 4 * I_GU + 2 * I_DN + I_IN + I_GLU + 2 * I_OH + I_PG + I_PP;
#ifndef TR_REPS
#define TR_REPS 1
#endif
    for (int trr = 0; trr < TR_REPS; ++trr)
    for (int it = gw; it < NITEMS; it += NGW) {
        int r = it;
        if (r < I_GU) { p0_transpose_item(INP(3), D, FF, (bf16*)(ws + WS_W1GU), INP(2), 1, scr, r, lane); continue; } r -= I_GU;
        if (r < I_GU) { p0_transpose_item(INP(4), D, FF, (bf16*)(ws + WS_W1GU), INP(2), 2, scr, r, lane); continue; } r -= I_GU;
        if (r < I_DN) { p0_transpose_item(INP(5), FF, D, (bf16*)(ws + WS_W1D), nullptr, 0, scr, r, lane); continue; } r -= I_DN;
        if (r < I_IN) { p0_transpose_item(INP(7), D, DIN, (bf16*)(ws + WS_WIN), INP(6), 0, scr, r, lane); continue; } r -= I_IN;
        if (r < I_GLU) { p0_transpose_item(INP(16), DSSM, DSSM, (bf16*)(ws + WS_WGLU), nullptr, 0, scr, r, lane); continue; } r -= I_GLU;
        if (r < I_OH) { p0_transpose_item(INP(22), 1024, D, (bf16*)(ws + WS_WO), INP(20), 0, scr, r, lane, D); continue; } r -= I_OH;
        if (r < I_OH) { p0_transpose_item(INP(22) + (size_t)1024 * D, 1024, D, (bf16*)(ws + WS_WO) + 1024, INP(21), 0, scr, r, lane, D); continue; } r -= I_OH;
        if (r < I_GU) { p0_transpose_item(INP(24), D, FF, (bf16*)(ws + WS_W2GU), INP(23), 1, scr, r, lane); continue; } r -= I_GU;
        if (r < I_GU) { p0_transpose_item(INP(25), D, FF, (bf16*)(ws + WS_W2GU), INP(23), 2, scr, r, lane); continue; } r -= I_GU;
        if (r < I_DN) { p0_transpose_item(INP(26), FF, D, (bf16*)(ws + WS_W2D), nullptr, 0, scr, r, lane); continue; } r -= I_DN;
        if (r < I_PG) { p0_transpose_item(INP(28), D, D, (bf16*)(ws + WS_WPG), INP(27), 0, scr, r, lane); continue; } r -= I_PG;
        p0_transpose_item(INP(29), DPLE, D, (bf16*)(ws + WS_WPP), nullptr, 0, scr, r, lane);
    }
    const float* x = INP(0); bf16* xb = (bf16*)(ws + WS_HB); float* hpA = (float*)(ws + WS_HPA);
    const int nskip = (G > 128) ? 64 : 0;
    const int gw2 = ((int)blockIdx.x - nskip) * NWAVES + wave, NGW2 = (G - nskip) * NWAVES;
    if ((int)blockIdx.x >= nskip)
    for (int m = gw2; m < M; m += NGW2) {
        const f32x4* xr = (const f32x4*)(x + (size_t)m * D) + lane; float s = 0.f;
        unsigned long long* o8 = (unsigned long long*)(xb + (size_t)m * D) + lane;
#pragma unroll
        for (int j = 0; j < 8; ++j) { const f32x4 v = xr[64 * j]; s += (v[0] * v[0] + v[1] * v[1]) + (v[2] * v[2] + v[3] * v[3]);
            o8[64 * j] = (unsigned long long)pk2(v[0], v[1]) | ((unsigned long long)pk2(v[2], v[3]) << 32); }
        s = wave_sum(s);
        if (lane < 32) hpA[(size_t)m * 32 + lane] = lane == 0 ? s : 0.f;
    }
    const float* p = INP(1); bf16* pb = (bf16*)(ws + WS_PB);
    if ((int)blockIdx.x >= nskip)
    for (size_t i = (size_t)gw2 * 64 + lane; i < (size_t)M * DPLE / 4; i += (size_t)NGW2 * 64) { const f32x4 v = ((const f32x4*)p)[i];
        ((unsigned long long*)pb)[i] = (unsigned long long)pk2(v[0], v[1]) | ((unsigned long long)pk2(v[2], v[3]) << 32); }
}

__device__ __forceinline__ void gmlp_phase(const Args& a, LAS unsigned char* lds, int tid, int lane, int wave, int G) {
    constexpr int VP = 136;
    LAS bf16* LV = (LAS bf16*)lds; LAS bf16* LW = (LAS bf16*)(lds + 128 * VP * 2); LAS float* ST = (LAS float*)(lds + 2 * 128 * VP * 2);
    unsigned char* ws = WSP();
    const bf16* gv = (const bf16*)(ws + WS_GV); bf16* gu = (bf16*)(ws + WS_YCAT) + 1024;     const float* lnp = (const float*)(ws + WS_LNP); float* gsp = (float*)(ws + WS_GSP);
    const float* normv = INP(17); const float* w_s = INP(18); const float* b_s = INP(19);
    const int fr = lane & 15, q = lane >> 4;
    int h_staged = -1;
    for (int unit = blockIdx.x; unit < 1024; unit += G) {
        const int h = unit & 7, m0 = (unit >> 3) * 128;
        if (tid < 128) { const f32x4* pp = (const f32x4*)(lnp + (size_t)(m0 + tid) * 32); float s1 = 0.f, s2 = 0.f;
#pragma unroll
            for (int i = 0; i < 8; ++i) { const f32x4 v = pp[i]; s1 += v[0] + v[2]; s2 += v[1] + v[3]; }
            const float mean = s1 * (1.0f / 1024.0f), var = s2 * (1.0f / 1024.0f) - mean * mean;
            ST[2 * tid] = mean; ST[2 * tid + 1] = rsqrtf(fmaxf(var, 0.f) + EPS); }
        __syncthreads();
#pragma unroll
        for (int i = 0; i < 2; ++i) { const int id = tid + 512 * i, s = 2 * (id >> 4), pc = id & 15;
            const v4u w0 = *(const v4u*)(gv + (size_t)(m0 + s) * 1024 + h * 128 + pc * 8), w1 = *(const v4u*)(gv + (size_t)(m0 + s + 1) * 1024 + h * 128 + pc * 8);
            const float mean0 = ST[2 * s], rstd0 = ST[2 * s + 1], mean1 = ST[2 * s + 2], rstd1 = ST[2 * s + 3];
            const f32x4 g0 = *(const f32x4*)(normv + h * 128 + pc * 8), g1 = *(const f32x4*)(normv + h * 128 + pc * 8 + 4);
            const float v0[8] = {bflo(w0.x), bfhi(w0.x), bflo(w0.y), bfhi(w0.y), bflo(w0.z), bfhi(w0.z), bflo(w0.w), bfhi(w0.w)};
            const float v1[8] = {bflo(w1.x), bfhi(w1.x), bflo(w1.y), bfhi(w1.y), bflo(w1.z), bfhi(w1.z), bflo(w1.w), bfhi(w1.w)};
#pragma unroll
            for (int e = 0; e < 8; ++e) { const float gg = e < 4 ? g0[e & 3] : g1[e & 3];
                *(LAS unsigned*)(LV + (pc * 8 + e) * VP + s) = pk2((v0[e] - mean0) * rstd0 * gg, (v1[e] - mean1) * rstd1 * gg); } }
        if (h != h_staged) { h_staged = h;
#pragma unroll
        for (int i = 0; i < 8; ++i) { const int id = tid + 512 * i, t = id >> 5, sc = id & 31;
            const f32x4 w = *(const f32x4*)(w_s + ((size_t)h * 128 + t) * 128 + sc * 4);
            float v[4];
#pragma unroll
            for (int e = 0; e < 4; ++e) v[e] = (sc * 4 + e <= t) ? w[e] : 0.f;
            *(LAS v2u*)(LW + t * VP + sc * 4) = (v2u){pk2(v[0], v[1]), pk2(v[2], v[3])}; }
        }
        __syncthreads();
        f32x4 acc[8];
#pragma unroll
        for (int pt = 0; pt < 8; ++pt) acc[pt] = (f32x4){0.f, 0.f, 0.f, 0.f};
        const int nks = (16 * wave + 15) / 32 + 1;
        for (int ks = 0; ks < nks; ++ks) {
            const bf16x8 wf = *(const LAS bf16x8*)(LW + (16 * wave + fr) * VP + ks * 32 + 8 * q);
#pragma unroll
            for (int pt = 0; pt < 8; ++pt) { const bf16x8 vf = *(const LAS bf16x8*)(LV + (16 * pt + fr) * VP + ks * 32 + 8 * q);
                acc[pt] = __builtin_amdgcn_mfma_f32_16x16x32_bf16(vf, wf, acc[pt], 0, 0, 0); }
        }
        const int t = 16 * wave + fr, row = m0 + t; const float bias = b_s[h * 128 + t]; float ss = 0.f;
#pragma unroll
        for (int pt = 0; pt < 8; ++pt) { bf16* gp = gu + (size_t)row * 2048 + h * 128 + 16 * pt + 4 * q; const v2u w = *(const v2u*)gp;
            const float o0 = bflo(w.x) * (acc[pt][0] + bias), o1 = bfhi(w.x) * (acc[pt][1] + bias), o2 = bflo(w.y) * (acc[pt][2] + bias), o3 = bfhi(w.y) * (acc[pt][3] + bias);
            ss += (o0 * o0 + o1 * o1) + (o2 * o2 + o3 * o3);
            *(v2u*)gp = (v2u){pk2(o0, o1), pk2(o2, o3)}; }
        ss += __shfl_xor(ss, 16); ss += __shfl_xor(ss, 32);
        if (q == 0) gsp[(size_t)row * 8 + h] = ss;
        __syncthreads();
    }
}

#if !S5_FAST
__device__ __forceinline__ void s5_phase(const Args& a, LAS unsigned char* lds, int tid, int lane, int wave, int G) {
    unsigned char* ws = WSP(); const bf16* zs = (const bf16*)(ws + WS_ZS); bf16* yg = (bf16*)(ws + WS_YG);
    const float* log_dt = INP(8); const float* a_re = INP(9); const float* a_im = INP(10); const float* b_re = INP(11); const float* b_im = INP(12);
    const float* c_re = INP(13); const float* c_im = INP(14); const float* dvec = INP(15);
    for (int job = blockIdx.x * NWAVES + wave; job < 256; job += G * NWAVES) {
        const int b = job >> 6, g = job & 63, n = lane;
        const float dt = expf(log_dt[g]), lr = fminf(a_re[g * 64 + n], -1e-4f), li = a_im[g * 64 + n];
        const float mag = expf(lr * dt), ang = li * dt, abr = mag * cosf(ang), abi = mag * sinf(ang);
        const float xr = abr - 1.0f, xi = abi, den = lr * lr + li * li, zr = (xr * lr + xi * li) / den, zi = (xi * lr - xr * li) / den;
        float bbr[16], bbi[16], cr[16], ci[16];
#pragma unroll
        for (int p = 0; p < 16; ++p) { const float br = b_re[(g * 64 + n) * 16 + p], bi = b_im[(g * 64 + n) * 16 + p]; bbr[p] = zr * br - zi * bi; bbi[p] = zr * bi + zi * br;
            cr[p] = c_re[(g * 16 + p) * 64 + n]; ci[p] = c_im[(g * 16 + p) * 64 + n]; }
        float sr = 0.f, si = 0.f;
        for (int t = 0; t < SEQ; ++t) {
            const size_t row = (size_t)b * SEQ + t;
            const v4u u0 = *(const v4u*)(zs + row * 1024 + 16 * g), u1 = *(const v4u*)(zs + row * 1024 + 16 * g + 8);
            const float uu[16] = {bflo(u0.x), bfhi(u0.x), bflo(u0.y), bfhi(u0.y), bflo(u0.z), bfhi(u0.z), bflo(u0.w), bfhi(u0.w), bflo(u1.x), bfhi(u1.x), bflo(u1.y), bfhi(u1.y), bflo(u1.z), bfhi(u1.z), bflo(u1.w), bfhi(u1.w)};
            float dr = 0.f, di = 0.f;
#pragma unroll
            for (int p = 0; p < 16; ++p) { dr += bbr[p] * uu[p]; di += bbi[p] * uu[p]; }
            const float nsr = abr * sr - abi * si + dr, nsi = abr * si + abi * sr + di; sr = nsr; si = nsi;
            float y[16];
#pragma unroll
            for (int p = 0; p < 16; ++p) { float v = wave_sum(cr[p] * sr - ci[p] * si); v += dvec[g * 16 + p] * uu[p]; y[p] = pg8::gelu_tanh(v); }
            if (lane == 0) { v4u o0, o1; o0.x = pk2(y[0], y[1]); o0.y = pk2(y[2], y[3]); o0.z = pk2(y[4], y[5]); o0.w = pk2(y[6], y[7]); o1.x = pk2(y[8], y[9]); o1.y = pk2(y[10], y[11]); o1.z = pk2(y[12], y[13]); o1.w = pk2(y[14], y[15]);
                *(v4u*)(yg + row * 1024 + 16 * g) = o0; *(v4u*)(yg + row * 1024 + 16 * g + 8) = o1; }
        }
    }
}
#else
template <int N> __device__ __forceinline__ float dpp_shr(float v) { return __int_as_float(__builtin_amdgcn_update_dpp(0, __float_as_int(v), 0x110 + N, 0xF, 0xF, true)); }

template <bool DO_Y> __device__ __forceinline__ void s5_superblock(const bf16* zs, bf16* yg, const LAS unsigned char* img, const LAS float* CST, LAS float* scp, size_t t0, int g, int lane, GAS f32x4* ebuf) {
    const int fr = lane & 15, q = lane >> 4;
    f32x4 E[8];
    if constexpr (!DO_Y) {
        bf16x8 U[8];
#pragma unroll
        for (int ks = 0; ks < 8; ++ks) U[ks] = *(const GAS bf16x8*)(zs + (t0 + 16 * fr + 2 * ks + (q >> 1)) * 1024 + 16 * g + 8 * (q & 1));
        const LAS bf16x8* w1p = (const LAS bf16x8*)(img + lane * 16);
#pragma unroll
        for (int mt = 0; mt < 8; ++mt) {
            E[mt] = (f32x4){0.f, 0.f, 0.f, 0.f};
#pragma unroll
            for (int ks = 0; ks < 8; ++ks) E[mt] = __builtin_amdgcn_mfma_f32_16x16x32_bf16(w1p[64 * (mt * 8 + ks)], U[ks], E[mt], 0, 0, 0);
            ebuf[64 * mt + lane] = E[mt];
            asm volatile("" ::: "memory");
        }
    } else {
#pragma unroll
        for (int mt = 0; mt < 8; ++mt) E[mt] = ebuf[64 * mt + lane];
    }
#pragma unroll
    for (int mt = 0; mt < 4; ++mt) { const f32x4 mr = *(const LAS f32x4*)(CST + 0 * 64 + 16 * mt + 4 * q), mi = *(const LAS f32x4*)(CST + 1 * 64 + 16 * mt + 4 * q);
        const f32x4 cr = *(const LAS f32x4*)(scp + 16 * mt + 4 * q), ci = *(const LAS f32x4*)(scp + 16 * (mt + 4) + 4 * q);
        if (fr == 0) { E[mt] += mr * cr - mi * ci; E[mt + 4] += mr * ci + mi * cr; } }
#define S5_LEVEL(LV, DD) { \
    _Pragma("unroll") for (int mt = 0; mt < 4; ++mt) { const f32x4 mr = *(const LAS f32x4*)(CST + ((LV) * 2 + 0) * 64 + 16 * mt + 4 * q), mi = *(const LAS f32x4*)(CST + ((LV) * 2 + 1) * 64 + 16 * mt + 4 * q); \
        _Pragma("unroll") for (int j = 0; j < 4; ++j) { const float sr = dpp_shr<DD>(E[mt][j]), si = dpp_shr<DD>(E[mt + 4][j]); \
            E[mt][j] += mr[j] * sr - mi[j] * si; E[mt + 4][j] += mr[j] * si + mi[j] * sr; } } }
    __builtin_amdgcn_sched_barrier(0); S5_LEVEL(0, 1) __builtin_amdgcn_sched_barrier(0); S5_LEVEL(1, 2) __builtin_amdgcn_sched_barrier(0); S5_LEVEL(2, 4) __builtin_amdgcn_sched_barrier(0); S5_LEVEL(3, 8) __builtin_amdgcn_sched_barrier(0);
#undef S5_LEVEL
    bf16x8 Sb[4];
    if constexpr (DO_Y) {
#pragma unroll
        for (int ks = 0; ks < 4; ++ks) { float x[8];
#pragma unroll
            for (int h = 0; h < 2; ++h) { const f32x4 c = *(const LAS f32x4*)(scp + 16 * (2 * ks + h) + 4 * q);
#pragma unroll
                for (int j = 0; j < 4; ++j) { const float sh = dpp_shr<1>(E[2 * ks + h][j]); x[4 * h + j] = fr == 0 ? c[j] : sh; } }
            v4u w; w.x = pg8::cvt_pk_bf16(x[0], x[1]); w.y = pg8::cvt_pk_bf16(x[2], x[3]); w.z = pg8::cvt_pk_bf16(x[4], x[5]); w.w = pg8::cvt_pk_bf16(x[6], x[7]);
            Sb[ks] = __builtin_bit_cast(bf16x8, w); }
    }
    asm volatile("s_waitcnt lgkmcnt(0)" ::: "memory");
    if (fr == 15) {
#pragma unroll
        for (int mt = 0; mt < 8; ++mt) *(LAS f32x4*)(scp + 16 * mt + 4 * q) = E[mt]; }
    if constexpr (DO_Y) {
        asm volatile("" ::: "memory");
        bf16x8 U2[8];
#pragma unroll
        for (int ks = 0; ks < 8; ++ks) U2[ks] = *(const GAS bf16x8*)(zs + (t0 + 16 * fr + 2 * ks + (q >> 1)) * 1024 + 16 * g + 8 * (q & 1));
        const LAS bf16x8* w3c = (const LAS bf16x8*)(img + 65536 + lane * 16);
        const LAS bf16x8* w3t = (const LAS bf16x8*)(img + 131072 + lane * 16);
        GAS v2u* yp = (GAS v2u*)(yg + (t0 + 16 * fr) * 1024 + 16 * g + 4 * q);
#pragma unroll
        for (int mt = 0; mt < 16; ++mt) {
            f32x4 acc = (f32x4){0.f, 0.f, 0.f, 0.f};
#pragma unroll
            for (int ks = 0; ks < 4; ++ks) acc = __builtin_amdgcn_mfma_f32_16x16x32_bf16(w3c[64 * (4 * mt + ks)], Sb[ks], acc, 0, 0, 0);
#pragma unroll
            for (int ks = 0; ks <= mt / 2; ++ks) acc = __builtin_amdgcn_mfma_f32_16x16x32_bf16(w3t[64 * (mt - 2 * ks)], U2[ks], acc, 0, 0, 0);
            const float y0 = pg8::gelu_tanh(acc[0]), y1 = pg8::gelu_tanh(acc[1]), y2 = pg8::gelu_tanh(acc[2]), y3 = pg8::gelu_tanh(acc[3]);
            yp[256 * mt] = (v2u){pg8::cvt_pk_bf16(y0, y1), pg8::cvt_pk_bf16(y2, y3)};
            asm volatile("" ::: "memory");
        }
    }
}

__device__ __forceinline__ void s5_fill_image(const unsigned char* ws, LAS unsigned char* lds, int g, int tid) {
    const GAS v4u* src = (const GAS v4u*)(ws + WS_S5W1 + (size_t)g * S5_IMG_BYTES) + tid; LAS v4u* dst = (LAS v4u*)lds + tid;
#pragma unroll 6
    for (int i = 0; i < S5_IMG_BYTES / 16 / 512; ++i) dst[512 * i] = src[512 * i];
}
__device__ __forceinline__ void s5_phase(const Args& a, LAS unsigned char* lds, int tid, int lane, int wave, int G, bool prefetched) {
    unsigned char* ws = WSP(); const bf16* zs = (const bf16*)(ws + WS_ZS); bf16* yg = (bf16*)(ws + WS_YG);
    LAS float* CST = (LAS float*)(lds + S5_IMG_BYTES); LAS float* ESEG = CST + 640; LAS float* SCW = ESEG + 1024;
    static_assert(S5_IMG_BYTES + (640 + 2048) * 4 <= MISC_OFF, "S5 LDS map");
    const int q = lane >> 4, fr = lane & 15;
    for (int job = blockIdx.x; job < 256; job += G) {
        const int b = job >> 6, g = job & 63;
        const float* SC = (const float*)(ws + WS_S5C) + (size_t)g * 640;
        for (int i = tid; i < 640; i += 512) CST[i] = SC[i];
        if (!(prefetched && job == (int)blockIdx.x)) s5_fill_image(ws, lds, g, tid);
        LAS float* eseg = ESEG + wave * 128; LAS float* scw = SCW + wave * 128;
        eseg[lane] = 0.f; eseg[64 + lane] = 0.f;
        __syncthreads();
        const size_t tb = (size_t)b * SEQ + 512 * wave;
        GAS f32x4* ebase = (GAS f32x4*)(ws + WS_HB) + ((size_t)job * NWAVES + wave) * 1024;
#ifndef NO_PASSA
#pragma unroll 1
        for (int sb = 0; sb < 2; ++sb) s5_superblock<false>(zs, yg, lds, CST, eseg, tb + 256 * sb, g, lane, ebase + 512 * sb);
#endif
        __syncthreads();
        if (fr == 0) {
            f32x4 sr[4], si[4];
#pragma unroll
            for (int mt = 0; mt < 4; ++mt) { sr[mt] = (f32x4){0.f, 0.f, 0.f, 0.f}; si[mt] = (f32x4){0.f, 0.f, 0.f, 0.f}; }
            for (int w2 = 0; w2 < wave; ++w2) {
#pragma unroll
                for (int mt = 0; mt < 4; ++mt) { const f32x4 mr = *(const LAS f32x4*)(CST + 8 * 64 + 16 * mt + 4 * q), mi = *(const LAS f32x4*)(CST + 9 * 64 + 16 * mt + 4 * q);
                    const f32x4 er = *(const LAS f32x4*)(ESEG + w2 * 128 + 16 * mt + 4 * q), ei = *(const LAS f32x4*)(ESEG + w2 * 128 + 16 * (mt + 4) + 4 * q);
                    const f32x4 nr = mr * sr[mt] - mi * si[mt] + er, ni = mr * si[mt] + mi * sr[mt] + ei; sr[mt] = nr; si[mt] = ni; }
            }
#pragma unroll
            for (int mt = 0; mt < 4; ++mt) { *(LAS f32x4*)(scw + 16 * mt + 4 * q) = sr[mt]; *(LAS f32x4*)(scw + 16 * (mt + 4) + 4 * q) = si[mt]; }
        }
#ifndef NO_PASSC
#pragma unroll 1
        for (int sb = 0; sb < 2; ++sb) s5_superblock<true>(zs, yg, lds, CST, scw, tb + 256 * sb, g, lane, ebase + 512 * sb);
#endif
        __syncthreads();
    }
}
#endif

__device__ __forceinline__ void final_phase(const Args& a, int lane, int wave, int G, int c_x, bool loc_ok) {
    const float* hp = (const float*)(WSP() + WS_HPA); const float* gf = INP(30); float* out = OUTP();
    const int nw = loc_ok ? (G / 8) * NWAVES : G * NWAVES, w0 = loc_ok ? (c_x >> 3) * NWAVES + wave : (int)blockIdx.x * NWAVES + wave;
    const int mbase = loc_ok ? (c_x & 7) * (M / 8) : 0, mcnt = loc_ok ? M / 8 : M;
    for (int mi = w0; mi < mcnt; mi += nw) {
        const int m = mbase + mi;
        float s = lane < 32 ? hp[(size_t)m * 32 + lane] : 0.f; s = wave_sum(s);
        const float r = rsqrtf(s * (1.0f / 2048.0f) + EPS);
        f32x4* o = (f32x4*)(out + (size_t)m * D) + lane; const f32x4* gg = (const f32x4*)gf + lane;
#pragma unroll
        for (int j = 0; j < 8; ++j) { const f32x4 v = o[64 * j], w = gg[64 * j]; o[64 * j] = v * r * w; }
    }
}

constexpr int N_PHASES = 12;
__global__ void __launch_bounds__(NWAVES * 64, 2) fwd_kernel(Args args) {
    extern __shared__ __attribute__((aligned(16))) unsigned char lds_raw[];
    LAS unsigned char* lds = (LAS unsigned char*)lds_raw;
    const int tid = threadIdx.x, lane = tid & 63, wave = __builtin_amdgcn_readfirstlane(tid >> 6), G = gridDim.x, c = blockIdx.x;
    unsigned char* ws = WSP();
    const int lo = KARG_INT(66), hi = KARG_INT(67);
    cg::grid_group grid = cg::this_grid();
    volatile LAS unsigned* MISC = (volatile LAS unsigned*)(lds + MISC_OFF);
    if (tid < 16) MISC[tid] = 0u;
    __syncthreads();
    unsigned* barw = (unsigned*)(WSP() + 16384);
    XcdBarrier bar; bar.bar = barw; bar.x = 0; bar.st = nullptr;
#ifndef PHMASK
#define PHMASK 0xFFFF
#endif
#define IN(k) (((PHMASK >> (k)) & 1) && lo <= (k) && (k) < hi)
#define SEAM(k) do { if (IN(k) && IN((k) + 1)) xcd_barrier(bar); } while (0)
#define SEAM_L(k) do { if (IN(k) && IN((k) + 1)) { if (loc_ok) xcd_local_barrier(bar); else xcd_barrier(bar); } } while (0)
#ifndef REPMASK
#define REPMASK 0
#endif
#define REP(k) ((REPMASK >> (k)) & 1)
#ifndef EXTRA_SYNCS
#define EXTRA_SYNCS 0
#endif
    bf16* hb = (bf16*)(ws + WS_HB); bf16* act = (bf16*)(ws + WS_ACT); float* hpA = (float*)(ws + WS_HPA); float* hpB = (float*)(ws + WS_HPB);
    bf16* ppb = (bf16*)(ws + WS_PP);

    for (int i = 0; i < EXTRA_SYNCS; ++i) grid.sync();
    bool s5_pref = false;
    for (int rep = 0; rep <= REP(0); ++rep) { if (rep) grid.sync();
    if (IN(0)) { if (blockIdx.x == 0) for (int i = tid; i < XCD_BAR_WORDS; i += NWAVES * 64) barw[i] = 0u;
        p0_prologue(args, lds, tid, lane, wave, G); } }
    int c_x = c; bool loc_ok = false;
    if (IN(0) && IN(1)) { grid.sync(); bar = xcd_barrier_post(barw, MISC + 8);
        if (tid == 0) { unsigned nloc, nx; xcd_barrier_complete(barw, bar.x, nloc, nx); MISC[8] = nloc; MISC[9] = nx; }
        __syncthreads();
        bool ok = (G % 8 == 0);
#pragma unroll
        for (unsigned j = 0; j < 16; ++j) { const unsigned cn = xb_ld(&barw[XB_XCNT(j)]); ok = ok && (cn == (j < 8 ? (unsigned)G / 8u : 0u)); }
        const unsigned rank = MISC[10];
#ifndef NO_LOCAL_SEAMS
        const int okf = __builtin_amdgcn_readfirstlane((ok && rank < (unsigned)G / 8u && MISC[8] == (unsigned)G / 8u) ? 1 : 0);
        if (okf) { c_x = __builtin_amdgcn_readfirstlane((int)(bar.x + 8u * rank)); loc_ok = true; }
#endif
    }
    for (int rep = 0; rep <= REP(1); ++rep) { if (rep) grid.sync();
    if (IN(1)) {
        { pg8::Gemm g{(const bf16*)(ws + WS_PB), (const bf16*)(ws + WS_WPP), M, D, DPLE}; pg8::StaticOrder S; S.init(M, D, G, c_x); pg8::EpiPlain E{ppb, D};
          pg8::gemm_phase<pg8::EpiPlain, pg8::StaticOrder, GP_ALIGN, GP_SP2>(lds, g, S, E); }
        { pg8::Gemm g{hb, (const bf16*)(ws + WS_W1GU), M, 2 * FF, D}; pg8::StaticOrder S; S.init(M, 2 * FF, G, c_x, WGM_UP); pg8::EpiSwiglu E{act, hpA, FF};
          pg8::gemm_phase<pg8::EpiSwiglu, pg8::StaticOrder, GP_ALIGN, GP_SP2>(lds, g, S, E); }
    } }
    SEAM_L(1);
    for (int rep = 0; rep <= REP(2); ++rep) { if (rep) grid.sync();
    if (IN(2)) {
        pg8::Gemm g{act, (const bf16*)(ws + WS_W1D), M, D, FF}; pg8::StaticOrder S; S.init(M, D, G, c_x, WGM_DN);
        pg8::EpiRes<0, false, true, true> E{INP(0), OUTP(), hb, hpB, nullptr, nullptr, 0.5f, 0.f};
        pg8::gemm_phase<pg8::EpiRes<0, false, true, true>, pg8::StaticOrder, GP_ALIGN, GP_SP2>(lds, g, S, E);
    } }
    SEAM(2);
    if (IN(3)) {
        pg8::Gemm g{hb, (const bf16*)(ws + WS_WIN), M, DIN, D}; pg8::StaticOrder S; S.init(M, DIN, G, c_x);
        pg8::EpiWin E{(bf16*)(ws + WS_ZS), (WS_YCAT - WS_ZS) / 2 + 1024, (WS_GV - WS_ZS) / 2, (float*)(ws + WS_LNP), hpB};
        pg8::gemm_phase<pg8::EpiWin, pg8::StaticOrder, GP_ALIGN, GP_SP2>(lds, g, S, E);
#if S5_FAST
        if (IN(4) && (int)blockIdx.x < 256) { s5_fill_image(ws, lds, (int)blockIdx.x & 63, tid); s5_pref = true; }
#endif
    }
    SEAM(3);
    if (IN(4)) { for (int rep = 0; rep <= REP(4); ++rep) { s5_phase(args, lds, tid, lane, wave, G, s5_pref && rep == 0); __syncthreads(); }
#ifndef NO_GMLP
 gmlp_phase(args, lds, tid, lane, wave, G);
#endif
 }
    SEAM(4);
    if (IN(5)) {
        pg8::Gemm g{(const bf16*)(ws + WS_YG), (const bf16*)(ws + WS_WGLU), M, DSSM, DSSM}; pg8::StaticOrder S; S.init(M, DSSM, G, c_x);
        pg8::EpiGlu E{(const bf16*)(ws + WS_YG), (bf16*)(ws + WS_YCAT), (float*)(ws + WS_SSP)};
        pg8::gemm_phase<pg8::EpiGlu, pg8::StaticOrder, GP_ALIGN, GP_SP2>(lds, g, S, E);
    }
    SEAM_L(5);
    if (IN(6)) {
        LAS float* midtab = (LAS float*)(lds + RING_BYTES);
        pg8::StaticOrder S; S.init(M, D, G, c_x);
        { const float* ssp = (const float*)(ws + WS_SSP); const float* gsp = (const float*)(ws + WS_GSP);
          for (int i = tid >> 8; i < 8; i += 2) { pg8::Unit u; if (!S.next(i, u)) break; const int row = u.pm * 256 + (tid & 255);
              const f32x4* sp = (const f32x4*)(ssp + (size_t)row * 16); const f32x4* gp = (const f32x4*)(gsp + (size_t)row * 8); float ssum = 0.f, gsum = 0.f;
#pragma unroll
              for (int j = 0; j < 4; ++j) { const f32x4 v = sp[j]; ssum += (v[0] + v[1]) + (v[2] + v[3]); }
#pragma unroll
              for (int j = 0; j < 2; ++j) { const f32x4 v = gp[j]; gsum += (v[0] + v[1]) + (v[2] + v[3]); }
              midtab[i * 256 + (tid & 255)] = sqrtf((gsum * (1.0f / 1024.0f) + EPS) / (ssum * (1.0f / 1024.0f) + EPS)); }
          __syncthreads(); }
        pg8::Gemm g{(const bf16*)(ws + WS_YCAT), (const bf16*)(ws + WS_WO), M, D, D};
        pg8::EpiRes<8, false, true, true> E{OUTP(), OUTP(), hb, hpA, (const float*)(ws + WS_GSP), nullptr, 0.f, 1.0f / 1024.0f};
        pg8::gemm_phase<pg8::EpiRes<8, false, true, true>, pg8::StaticOrder, GP_ALIGN, GP_SP2, true>(lds, g, S, E, midtab);
    }
    SEAM(6);
    if (IN(7)) {
        pg8::Gemm g{hb, (const bf16*)(ws + WS_W2GU), M, 2 * FF, D}; pg8::StaticOrder S; S.init(M, 2 * FF, G, c_x, WGM_UP); pg8::EpiSwiglu E{act, hpA, FF};
        pg8::gemm_phase<pg8::EpiSwiglu, pg8::StaticOrder, GP_ALIGN, GP_SP2>(lds, g, S, E);
    }
    SEAM_L(7);
    if (IN(8)) {
        pg8::Gemm g{act, (const bf16*)(ws + WS_W2D), M, D, FF}; pg8::StaticOrder S; S.init(M, D, G, c_x, WGM_DN);
        pg8::EpiRes<0, false, true, true> E{OUTP(), OUTP(), hb, hpB, nullptr, nullptr, 0.5f, 0.f};
        pg8::gemm_phase<pg8::EpiRes<0, false, true, true>, pg8::StaticOrder, GP_ALIGN, GP_SP2>(lds, g, S, E);
    }
    SEAM_L(8);
    if (IN(9)) {
        pg8::Gemm g{hb, (const bf16*)(ws + WS_WPG), M, D, D}; pg8::StaticOrder S; S.init(M, D, G, c_x);
        pg8::EpiRes<32, true, false, true> E{OUTP(), OUTP(), nullptr, hpA, hpB, ppb, 0.f, 1.0f / 2048.0f};
        pg8::gemm_phase<pg8::EpiRes<32, true, false, true>, pg8::StaticOrder, GP_ALIGN, GP_SP2>(lds, g, S, E);
    }
    SEAM_L(9);
    if (IN(10)) { final_phase(args, lane, wave, G, c_x, loc_ok); }
#undef IN
#undef SEAM
}

extern "C" void kernel_launch(void* const* d_in, const int* in_sizes, int n_in, void* d_out, int out_size, void* d_ws, size_t ws_size, hipStream_t stream) {
    if (n_in != 31 || out_size != M * D || ws_size < WS_END) { fprintf(stderr, "kernel_launch: unexpected shapes (n_in %d out %d ws %zu)\n", n_in, out_size, ws_size); return; }
    static int grid = 0;
    if (grid == 0) {
        int dev = 0, cus = 0, per_cu = 0;
        (void)hipGetDevice(&dev); (void)hipDeviceGetAttribute(&cus, hipDeviceAttributeMultiprocessorCount, dev);
        (void)hipFuncSetAttribute((const void*)fwd_kernel, hipFuncAttributeMaxDynamicSharedMemorySize, LDS_BYTES);
        (void)hipOccupancyMaxActiveBlocksPerMultiprocessor(&per_cu, (const void*)fwd_kernel, NWAVES * 64, LDS_BYTES);
        if (per_cu < 1) { fprintf(stderr, "kernel_launch: occupancy query says %d blocks/CU\n", per_cu); per_cu = 1; }
        (void)hipGetLastError();
        grid = cus * 1;
    }
    Args a{};
    for (int i = 0; i < 31; ++i) a.in[i] = (const float*)d_in[i];
    a.out = (float*)d_out; a.ws = (unsigned char*)d_ws;
#if ONE_LAUNCH
    a.ph_lo = 0; a.ph_hi = N_PHASES;
    void* kargs[] = {&a};
    hipError_t e = hipLaunchCooperativeKernel((const void*)fwd_kernel, dim3(grid), dim3(NWAVES * 64), kargs, LDS_BYTES, stream);
    if (e != hipSuccess) fprintf(stderr, "cooperative launch failed: %s (grid %d)\n", hipGetErrorString(e), grid);
#else
    for (int ph = 0; ph < 11; ++ph) { a.ph_lo = ph; a.ph_hi = ph + 1; hipLaunchKernelGGL(fwd_kernel, dim3(grid), dim3(NWAVES * 64), LDS_BYTES, stream, a); }
#endif
}
```

```cpp
#include <hip/hip_runtime.h>
#include <hip/hip_cooperative_groups.h>
#include <cstdio>
#include <cstdint>
namespace cg = cooperative_groups;
#define S5_FAST 1
#define ONE_LAUNCH 1
#define PG8_WGM 4
#define PG8_A_AUX 0
#define PG8_B_AUX 1
#ifndef PG8_WGM
#define PG8_WGM 8
#endif
namespace pg8 {
#define PG8_LAS __attribute__((address_space(3)))
typedef unsigned short bf16_t;
typedef short bf16x8 __attribute__((ext_vector_type(8)));
typedef float f32x4 __attribute__((ext_vector_type(4)));
typedef unsigned u32x4 __attribute__((ext_vector_type(4)));
constexpr int BM = 256, BK = 64, HALF = 128, HTB = HALF * BK * 2  , STAGE_BYTES = 8 * HTB, NXCD = 8, WGM = PG8_WGM;

__host__ __device__ __forceinline__ int lds_byte(int r, int c) { const int st = (r >> 4) * 2 + (c >> 5), rr = r & 15, cc = c & 31, ob = rr * 64 + cc * 2; return st * 1024 + (ob ^ (((ob >> 9) & 1) << 5)); }
__host__ __device__ __forceinline__ void stage_rc(int b, int& R, int& C) { const int st = b / 1024, sb = b % 1024, swz = sb ^ (((sb >> 9) & 1) << 5); R = (st >> 1) * 16 + swz / 64; C = (st & 1) * 32 + (swz % 64) / 2; }
__host__ __device__ __forceinline__ int perm32(int rho) { const int n = rho >> 4, i = rho & 15; return 8 * (i >> 2) + 4 * n + (i & 3); }

struct Unit { int pm, pn; };
struct Gemm { const bf16_t* A; const bf16_t* Bt; int M, N, K; };

struct StaticOrder {
    int nM, nN, nwg, G, c, wgm;
    __host__ __device__ void init(int M, int N, int G_, int c_, int wgm_ = PG8_WGM) { nM = M / BM; nN = N / BM; nwg = nM * nN; G = G_; c = c_; wgm = wgm_; }
    __host__ __device__ __forceinline__ bool next(int i, Unit& u) const {
        const long L = (long)i * G + c; if (L >= nwg) return false;
        int wgid = (int)L; { const int q = nwg / NXCD, r = nwg % NXCD, xcd = wgid % NXCD, off = wgid / NXCD; wgid = (xcd < r ? xcd * (q + 1) : r * (q + 1) + (xcd - r) * q) + off; }
        const int nig = wgm * nN, gid = wgid / nig, fm = gid * wgm, gsz = (nM - fm) < wgm ? (nM - fm) : wgm;
        u.pm = fm + ((wgid % nig) % gsz); u.pn = (wgid % nig) / gsz; return true;
    }
    __device__ __forceinline__ void a_ready(const Unit&) const {}
    __device__ __forceinline__ void done(const Unit&) const {}
};

__device__ __forceinline__ unsigned cvt_pk_bf16(float lo, float hi) { unsigned r; asm volatile("v_cvt_pk_bf16_f32 %0, %1, %2" : "=v"(r) : "v"(lo), "v"(hi)); return r; }
typedef float f32x2 __attribute__((ext_vector_type(2)));
constexpr float RMS_EPS = 1e-6f;
__device__ __forceinline__ float fast_sigmoid(float x) { return __builtin_amdgcn_rcpf(1.0f + __expf(-x)); }
__device__ __forceinline__ float gelu_tanh(float x) { const float u = x * (1.5957691216f + 0.0713548163f * x * x); return x * fast_sigmoid(u); }
__device__ __forceinline__ float bf_lo(unsigned w) { return __uint_as_float(w << 16); }
__device__ __forceinline__ float bf_hi(unsigned w) { return __uint_as_float(w & 0xffff0000u); }

template <int NP> __device__ __forceinline__ float row_total(const float* part, int row, int fq) {
    constexpr int PER = NP / 4;
    const float* p = part + (size_t)row * NP + fq * PER;
    float s;
    if constexpr (PER == 8) { const f32x4 a = *(const f32x4*)p, b = *(const f32x4*)(p + 4); s = ((a[0] + a[1]) + (a[2] + a[3])) + ((b[0] + b[1]) + (b[2] + b[3])); }
    else if constexpr (PER == 4) { const f32x4 a = *(const f32x4*)p; s = (a[0] + a[1]) + (a[2] + a[3]); }
    else { const f32x2 a = *(const f32x2*)p; s = a[0] + a[1]; }
    s += __shfl_xor(s, 16); s += __shfl_xor(s, 32);
    return s;
}

struct EpiSwiglu {
    static constexpr bool PERM = true, AFTER_DRAIN = false;
    bf16_t* O; const float* part; int ldo;
    __device__ __forceinline__ void operator()(const f32x4 (&acc)[2][2][4][2], const Unit& u, int wr, int wc, int fr, int fq) const {
        const int row0 = u.pm * BM + wr * 64 + fr, col0 = u.pn * 128 + wc * 32 + 8 * fq;
#ifndef EPI_SW_REPS
#define EPI_SW_REPS 1
#endif
#pragma unroll 1
        for (int rep_ = 0; rep_ < EPI_SW_REPS; ++rep_)
#pragma unroll
        for (int ai = 0; ai < 2; ++ai)
#pragma unroll
            for (int m = 0; m < 4; ++m) {
                const int row = row0 + ai * HALF + m * 16;
                const float r = rsqrtf(row_total<32>(part, row, fq) * (1.0f / 2048.0f) + RMS_EPS);
                f32x4 o0, o1;
#pragma unroll
                for (int j = 0; j < 4; ++j) { const float g = acc[ai][0][m][0][j] * r, up = acc[ai][1][m][0][j] * r; o0[j] = g * fast_sigmoid(g) * up; }
#pragma unroll
                for (int j = 0; j < 4; ++j) { const float g = acc[ai][0][m][1][j] * r, up = acc[ai][1][m][1][j] * r; o1[j] = g * fast_sigmoid(g) * up; }
                u32x4 w; w.x = cvt_pk_bf16(o0[0], o0[1]); w.y = cvt_pk_bf16(o0[2], o0[3]); w.z = cvt_pk_bf16(o1[0], o1[1]); w.w = cvt_pk_bf16(o1[2], o1[3]);
                *(u32x4*)(O + (size_t)row * ldo + col0) = w;
                asm volatile("" ::: "memory");
            }
    }
};

template <int NP> __device__ __forceinline__ void row_scales(const float* part, int row0, int fq, float inv_width, float (&sc)[8]) {
    constexpr int PER = NP / 4;
    float s[8];
    if constexpr (PER == 8) {
        f32x4 a[8], b[8];
#pragma unroll
        for (int i = 0; i < 8; ++i) { const float* p = part + (size_t)(row0 + (i >> 2) * HALF + (i & 3) * 16) * NP + fq * PER; a[i] = *(const f32x4*)p; b[i] = *(const f32x4*)(p + 4); }
#pragma unroll
        for (int i = 0; i < 8; ++i) s[i] = ((a[i][0] + a[i][1]) + (a[i][2] + a[i][3])) + ((b[i][0] + b[i][1]) + (b[i][2] + b[i][3]));
    } else if constexpr (PER == 4) {
        f32x4 a[8];
#pragma unroll
        for (int i = 0; i < 8; ++i) a[i] = *(const f32x4*)(part + (size_t)(row0 + (i >> 2) * HALF + (i & 3) * 16) * NP + fq * PER);
#pragma unroll
        for (int i = 0; i < 8; ++i) s[i] = (a[i][0] + a[i][1]) + (a[i][2] + a[i][3]);
    } else {
        f32x2 a[8];
#pragma unroll
        for (int i = 0; i < 8; ++i) a[i] = *(const f32x2*)(part + (size_t)(row0 + (i >> 2) * HALF + (i & 3) * 16) * NP + fq * PER);
#pragma unroll
        for (int i = 0; i < 8; ++i) s[i] = a[i][0] + a[i][1];
    }
#pragma unroll
    for (int i = 0; i < 8; ++i) { s[i] += __shfl_xor(s[i], 16); s[i] += __shfl_xor(s[i], 32); sc[i] = __builtin_amdgcn_rsqf(s[i] * inv_width + RMS_EPS); }
}

template <int SCALE_NP, bool GATE, bool WB, bool WP> struct EpiRes {
    static constexpr bool PERM = true, AFTER_DRAIN = false;
    const float* resid; float* out; bf16_t* hb; float* pout; const float* pin; const bf16_t* pp; float alpha; float inv_width;
    __device__ __forceinline__ void operator()(const f32x4 (&acc)[2][2][4][2], const Unit& u, int wr, int wc, int fr, int fq) const {
        const int row0 = u.pm * BM + wr * 64 + fr, col0 = u.pn * BM + wc * 32 + 8 * fq;
        float sc[8];
        if constexpr (SCALE_NP > 0) row_scales<SCALE_NP>(pin, row0, fq, inv_width, sc);
        f32x4 R[2][4]; u32x4 P[2][2];
#define EPIRES_LOAD(i, buf) { const size_t off_ = (size_t)(row0 + ((i) >> 2) * HALF + ((i) & 3) * 16) * 2048 + col0; \
            R[buf][0] = *(const f32x4*)(resid + off_); R[buf][1] = *(const f32x4*)(resid + off_ + 4); R[buf][2] = *(const f32x4*)(resid + off_ + HALF); R[buf][3] = *(const f32x4*)(resid + off_ + HALF + 4); \
            if constexpr (GATE) { P[buf][0] = *(const u32x4*)(pp + off_); P[buf][1] = *(const u32x4*)(pp + off_ + HALF); } }
        EPIRES_LOAD(0, 0)
#pragma unroll
        for (int i = 0; i < 8; ++i) {
            const int ai = i >> 2, m = i & 3, row = row0 + ai * HALF + m * 16, cb = i & 1;
            if (i < 7) EPIRES_LOAD(i + 1, cb ^ 1)
            const float scv = SCALE_NP > 0 ? sc[i] : alpha;
            float ss = 0.f;
#pragma unroll
            for (int bj = 0; bj < 2; ++bj) {
                const size_t off = (size_t)row * 2048 + col0 + bj * HALF;
                f32x4 a0 = acc[ai][bj][m][0] * scv, a1 = acc[ai][bj][m][1] * scv;
                if constexpr (GATE) {
                    const u32x4 pw = P[cb][bj];
                    a0[0] = fast_sigmoid(a0[0]) * bf_lo(pw.x); a0[1] = fast_sigmoid(a0[1]) * bf_hi(pw.x); a0[2] = fast_sigmoid(a0[2]) * bf_lo(pw.y); a0[3] = fast_sigmoid(a0[3]) * bf_hi(pw.y);
                    a1[0] = fast_sigmoid(a1[0]) * bf_lo(pw.z); a1[1] = fast_sigmoid(a1[1]) * bf_hi(pw.z); a1[2] = fast_sigmoid(a1[2]) * bf_lo(pw.w); a1[3] = fast_sigmoid(a1[3]) * bf_hi(pw.w);
                }
                const f32x4 o0 = R[cb][2 * bj] + a0, o1 = R[cb][2 * bj + 1] + a1;
                *(f32x4*)(out + off) = o0; *(f32x4*)(out + off + 4) = o1;
                if constexpr (WP) ss += ((o0[0] * o0[0] + o0[1] * o0[1]) + (o0[2] * o0[2] + o0[3] * o0[3])) + ((o1[0] * o1[0] + o1[1] * o1[1]) + (o1[2] * o1[2] + o1[3] * o1[3]));
                if constexpr (WB) { u32x4 w; w.x = cvt_pk_bf16(o0[0], o0[1]); w.y = cvt_pk_bf16(o0[2], o0[3]); w.z = cvt_pk_bf16(o1[0], o1[1]); w.w = cvt_pk_bf16(o1[2], o1[3]); *(u32x4*)(hb + off) = w; }
            }
            if constexpr (WP) { ss += __shfl_xor(ss, 16); ss += __shfl_xor(ss, 32); if (fq == 0) pout[(size_t)row * 32 + u.pn * 4 + wc] = ss; }
            asm volatile("" ::: "memory");
        }
#undef EPIRES_LOAD
    }
};

struct EpiWin {
    static constexpr bool PERM = true, AFTER_DRAIN = false;
    bf16_t* zs; size_t off_u, off_v; float* lnp; const float* part;
    __device__ __forceinline__ void operator()(const f32x4 (&acc)[2][2][4][2], const Unit& u, int wr, int wc, int fr, int fq) const {
        const int kind = u.pn >> 2, ct = u.pn & 3;
        const int row0 = u.pm * BM + wr * 64 + fr, col0 = ct * BM + wc * 32 + 8 * fq;
        bf16_t* dst = zs + (size_t)(kind == 1) * off_u + (size_t)(kind == 2) * off_v; const int ldd = 1024 << (kind == 1);
#pragma unroll
        for (int ai = 0; ai < 2; ++ai)
#pragma unroll
            for (int m = 0; m < 4; ++m) {
                const int row = row0 + ai * HALF + m * 16;
                const float r = rsqrtf(row_total<32>(part, row, fq) * (1.0f / 2048.0f) + RMS_EPS);
                float s1 = 0.f, s2 = 0.f;
#pragma unroll
                for (int bj = 0; bj < 2; ++bj) {
                    f32x4 o0 = acc[ai][bj][m][0] * r, o1 = acc[ai][bj][m][1] * r;
                    if (kind != 0) {
#pragma unroll
                        for (int j = 0; j < 4; ++j) { o0[j] = gelu_tanh(o0[j]); o1[j] = gelu_tanh(o1[j]); } }
                    s1 += ((o0[0] + o0[1]) + (o0[2] + o0[3])) + ((o1[0] + o1[1]) + (o1[2] + o1[3]));
                    s2 += ((o0[0] * o0[0] + o0[1] * o0[1]) + (o0[2] * o0[2] + o0[3] * o0[3])) + ((o1[0] * o1[0] + o1[1] * o1[1]) + (o1[2] * o1[2] + o1[3] * o1[3]));
                    u32x4 w; w.x = cvt_pk_bf16(o0[0], o0[1]); w.y = cvt_pk_bf16(o0[2], o0[3]); w.z = cvt_pk_bf16(o1[0], o1[1]); w.w = cvt_pk_bf16(o1[2], o1[3]);
                    *(u32x4*)(dst + (size_t)row * ldd + col0 + bj * HALF) = w;
                }
                if (kind == 2) {
                    s1 += __shfl_xor(s1, 16); s1 += __shfl_xor(s1, 32); s2 += __shfl_xor(s2, 16); s2 += __shfl_xor(s2, 32);
                    if (fq == 0) *(f32x2*)(lnp + ((size_t)row * 16 + ct * 4 + wc) * 2) = (f32x2){s1, s2};
                }
                asm volatile("" ::: "memory");
            }
    }
};

struct EpiGlu {
    static constexpr bool PERM = true, AFTER_DRAIN = false;
    const bf16_t* yg; bf16_t* ys; float* ssp;
    __device__ __forceinline__ void operator()(const f32x4 (&acc)[2][2][4][2], const Unit& u, int wr, int wc, int fr, int fq) const {
        const int row0 = u.pm * BM + wr * 64 + fr, col0 = u.pn * BM + wc * 32 + 8 * fq;
#pragma unroll
        for (int ai = 0; ai < 2; ++ai)
#pragma unroll
            for (int m = 0; m < 4; ++m) {
                const int row = row0 + ai * HALF + m * 16;
                float ss = 0.f;
#pragma unroll
                for (int bj = 0; bj < 2; ++bj) {
                    const size_t off = (size_t)row * 1024 + col0 + bj * HALF, offo = (size_t)row * 2048 + col0 + bj * HALF;
                    const u32x4 yw = *(const u32x4*)(yg + off);
                    float o[8];
                    o[0] = bf_lo(yw.x) * fast_sigmoid(acc[ai][bj][m][0][0]); o[1] = bf_hi(yw.x) * fast_sigmoid(acc[ai][bj][m][0][1]);
                    o[2] = bf_lo(yw.y) * fast_sigmoid(acc[ai][bj][m][0][2]); o[3] = bf_hi(yw.y) * fast_sigmoid(acc[ai][bj][m][0][3]);
                    o[4] = bf_lo(yw.z) * fast_sigmoid(acc[ai][bj][m][1][0]); o[5] = bf_hi(yw.z) * fast_sigmoid(acc[ai][bj][m][1][1]);
                    o[6] = bf_lo(yw.w) * fast_sigmoid(acc[ai][bj][m][1][2]); o[7] = bf_hi(yw.w) * fast_sigmoid(acc[ai][bj][m][1][3]);
#pragma unroll
                    for (int e = 0; e < 8; ++e) ss += o[e] * o[e];
                    u32x4 w; w.x = cvt_pk_bf16(o[0], o[1]); w.y = cvt_pk_bf16(o[2], o[3]); w.z = cvt_pk_bf16(o[4], o[5]); w.w = cvt_pk_bf16(o[6], o[7]);
                    *(u32x4*)(ys + offo) = w;
                }
                ss += __shfl_xor(ss, 16); ss += __shfl_xor(ss, 32);
                if (fq == 0) ssp[(size_t)row * 16 + u.pn * 4 + wc] = ss;
            }
    }
};

struct EpiPlain {
    static constexpr bool PERM = true, AFTER_DRAIN = false;
    bf16_t* O; int ldo;
    __device__ __forceinline__ void operator()(const f32x4 (&acc)[2][2][4][2], const Unit& u, int wr, int wc, int fr, int fq) const {
        const int row0 = u.pm * BM + wr * 64 + fr, col0 = u.pn * BM + wc * 32 + 8 * fq;
#pragma unroll
        for (int ai = 0; ai < 2; ++ai)
#pragma unroll
            for (int m = 0; m < 4; ++m)
#pragma unroll
                for (int bj = 0; bj < 2; ++bj) {
                    const f32x4 v0 = acc[ai][bj][m][0], v1 = acc[ai][bj][m][1];
                    u32x4 w; w.x = cvt_pk_bf16(v0[0], v0[1]); w.y = cvt_pk_bf16(v0[2], v0[3]); w.z = cvt_pk_bf16(v1[0], v1[1]); w.w = cvt_pk_bf16(v1[2], v1[3]);
                    *(u32x4*)(O + (size_t)(row0 + ai * HALF + m * 16) * ldo + col0 + bj * HALF) = w;
                }
    }
};
template <class Epi, class Sched, bool ALIGN_EPI = false, bool SP2 = false, bool MID = false>
__device__ __forceinline__ void gemm_phase(PG8_LAS unsigned char* lds, const Gemm g, const Sched& S, const Epi& E, const PG8_LAS float* midtab = nullptr) {
    int tid = threadIdx.x; asm volatile("" : "+v"(tid));
    const int wid = __builtin_amdgcn_readfirstlane(tid >> 6), lane = tid & 63, wr = wid >> 2, wc = wid & 3, fr = lane & 15, fq = lane >> 4;
    int K = g.K; asm volatile("" : "+s"(K));     const int nt = K / BK;
    unsigned voffA[2], voffB[2];
#pragma unroll
    for (int i = 0; i < 2; ++i) { int R, C; stage_rc(tid * 16 + i * 8192, R, C); const int Rb = Epi::PERM ? ((R & ~31) + perm32(R & 31)) : R;
        voffA[i] = (unsigned)(R * K + C) * 2u; voffB[i] = (unsigned)(Rb * K + C) * 2u; }
    const size_t kstep = (size_t)(BK * 2);
    const size_t hstep = (size_t)HALF * K * 2;
    const size_t tstep = 2 * hstep;
    const unsigned ldsw = (unsigned)wid * 1024u;
    const int aoff = lds_byte(wr * 64 + fr, fq * 8), boff = lds_byte(wc * 32 + fr, fq * 8);
#define PG8_SA(b, h) (((b) * 2 + (h)) * HTB)
#define PG8_SB(b, h) ((4 + (b) * 2 + (h)) * HTB)
#ifndef PG8_A_AUX
#define PG8_A_AUX 0
#endif
#ifndef PG8_B_AUX
#define PG8_B_AUX 0
#endif
#define PG8_AUX_voffA PG8_A_AUX
#define PG8_AUX_voffB PG8_B_AUX
#define PG8_STAGE(bufoff, gbase, voff) do { _Pragma("unroll") for (int _i = 0; _i < 2; ++_i) \
        __builtin_amdgcn_global_load_lds((const unsigned*)((const char*)(gbase) + (voff)[_i]), (PG8_LAS unsigned*)(lds + (bufoff) + ldsw + _i * 8192), 16, 0, PG8_AUX_##voff); } while (0)
#define PG8_LDA(dst, b, h) do { _Pragma("unroll") for (int m = 0; m < 4; ++m) _Pragma("unroll") for (int k = 0; k < 2; ++k) dst[m][k] = *(const PG8_LAS bf16x8*)(lds + PG8_SA(b, h) + aoff + m * 2048 + k * 1024); } while (0)
#define PG8_LDB(dst, b, h) do { _Pragma("unroll") for (int n = 0; n < 2; ++n) _Pragma("unroll") for (int k = 0; k < 2; ++k) dst[n][k] = *(const PG8_LAS bf16x8*)(lds + PG8_SB(b, h) + boff + n * 2048 + k * 1024); } while (0)
#define PG8_MMA(ai, bj, At, Bt) do { __builtin_amdgcn_s_setprio(1); _Pragma("unroll") for (int m = 0; m < 4; ++m) _Pragma("unroll") for (int n = 0; n < 2; ++n) _Pragma("unroll") for (int k = 0; k < 2; ++k) \
        acc[ai][bj][m][n] = __builtin_amdgcn_mfma_f32_16x16x32_bf16(Bt[n][k], At[m][k], acc[ai][bj][m][n], 0, 0, 0); __builtin_amdgcn_s_setprio(0); } while (0)
#define PG8_WAIT_V(n) asm volatile("s_waitcnt vmcnt(" #n ")" ::: "memory")
#define PG8_WAIT_L(n) asm volatile("s_waitcnt lgkmcnt(" #n ")" ::: "memory")
#define PG8_BAR __builtin_amdgcn_s_barrier()
#define PG8_SCHED __builtin_amdgcn_sched_barrier(0)
    Unit cur, nxt; int ui = 0;
    if (!S.next(0, cur)) return;
    f32x4 acc[2][2][4][2];
#pragma unroll
    for (int a = 0; a < 2; ++a)
#pragma unroll
        for (int b = 0; b < 2; ++b)
#pragma unroll
            for (int m = 0; m < 4; ++m)
#pragma unroll
                for (int n = 0; n < 2; ++n) acc[a][b][m][n] = (f32x4){0.f, 0.f, 0.f, 0.f};
    bf16x8 At[4][2], B0[2][2], B1[2][2];
    const char* cA = (const char*)g.A + (size_t)cur.pm * tstep; const char* cB = (const char*)g.Bt + (size_t)cur.pn * tstep;
    S.a_ready(cur);
    if constexpr (SP2) {
        PG8_STAGE(PG8_SB(0, 0), cB, voffB); PG8_STAGE(PG8_SB(0, 1), cB + hstep, voffB); PG8_STAGE(PG8_SA(0, 0), cA, voffA); PG8_STAGE(PG8_SA(0, 1), cA + hstep, voffA);
        if (wr == 1) PG8_BAR;
        PG8_WAIT_V(2); PG8_BAR;
        PG8_STAGE(PG8_SB(1, 0), cB + kstep, voffB); PG8_STAGE(PG8_SA(1, 0), cA + kstep, voffA); PG8_STAGE(PG8_SB(1, 1), cB + hstep + kstep, voffB);
        PG8_WAIT_V(6); PG8_BAR;
    } else {
        PG8_STAGE(PG8_SB(0, 0), cB, voffB); PG8_STAGE(PG8_SA(0, 0), cA, voffA); PG8_STAGE(PG8_SB(0, 1), cB + hstep, voffB); PG8_STAGE(PG8_SA(0, 1), cA + hstep, voffA);
        if (wr == 1) PG8_BAR;
        PG8_WAIT_V(4); PG8_BAR;
        PG8_STAGE(PG8_SB(1, 0), cB + kstep, voffB); PG8_STAGE(PG8_SA(1, 0), cA + kstep, voffA); PG8_STAGE(PG8_SB(1, 1), cB + hstep + kstep, voffB);
        PG8_WAIT_V(6); PG8_BAR;
    }
    for (;;) {
        const bool has_next = S.next(ui + 1, nxt);
        const char* nA = has_next ? (const char*)g.A + (size_t)nxt.pm * tstep : cA; const char* nB = has_next ? (const char*)g.Bt + (size_t)nxt.pn * tstep : cB;
        for (int t = 0; t < nt; t += 2) {
            const bool last = (t == nt - 2);
            const char* a1 = cA + (size_t)(t + 1) * kstep;
            const char* a2 = last ? nA : cA + (size_t)(t + 2) * kstep; const char* b2 = last ? nB : cB + (size_t)(t + 2) * kstep;
            const char* a3 = a2 + kstep; const char* b3 = b2 + kstep;
            if (last && has_next) S.a_ready(nxt);
            if constexpr (MID) { if (t == (nt >> 1)) {
#pragma unroll
                for (int ai = 0; ai < 2; ++ai)
#pragma unroll
                    for (int m = 0; m < 4; ++m) { const float f = midtab[(ui & 7) * 256 + ai * HALF + wr * 64 + m * 16 + fr];
#pragma unroll
                        for (int bj = 0; bj < 2; ++bj)
#pragma unroll
                            for (int n = 0; n < 2; ++n) acc[ai][bj][m][n] *= f; } } }
            if constexpr (SP2) {
            PG8_LDB(B0, 0, 0); PG8_LDB(B1, 0, 1); PG8_SCHED; PG8_LDA(At, 0, 0); PG8_STAGE(PG8_SA(1, 1), a1 + hstep, voffA);
            PG8_WAIT_V(8); PG8_WAIT_L(0); PG8_BAR; PG8_MMA(0, 0, At, B0); PG8_MMA(0, 1, At, B1); PG8_BAR; PG8_SCHED;
            PG8_LDA(At, 0, 1); PG8_STAGE(PG8_SB(0, 0), b2, voffB); PG8_STAGE(PG8_SB(0, 1), b2 + hstep, voffB); PG8_STAGE(PG8_SA(0, 0), a2, voffA);
            PG8_WAIT_V(8); PG8_WAIT_L(0); PG8_BAR; PG8_MMA(1, 0, At, B0); PG8_MMA(1, 1, At, B1); PG8_BAR; PG8_SCHED;
            PG8_LDB(B0, 1, 0); PG8_LDB(B1, 1, 1); PG8_SCHED; PG8_LDA(At, 1, 0); PG8_STAGE(PG8_SA(0, 1), a2 + hstep, voffA);
            PG8_WAIT_V(8); PG8_WAIT_L(0); PG8_BAR; PG8_MMA(0, 0, At, B0); PG8_MMA(0, 1, At, B1); PG8_BAR; PG8_SCHED;
            PG8_LDA(At, 1, 1); PG8_STAGE(PG8_SB(1, 0), b3, voffB); PG8_STAGE(PG8_SB(1, 1), b3 + hstep, voffB); PG8_STAGE(PG8_SA(1, 0), a3, voffA);
            PG8_WAIT_V(8); PG8_WAIT_L(0); PG8_BAR; PG8_MMA(1, 0, At, B0); PG8_MMA(1, 1, At, B1); PG8_BAR; PG8_SCHED;
            } else {
            PG8_LDB(B0, 0, 0); PG8_SCHED; PG8_LDA(At, 0, 0); PG8_STAGE(PG8_SA(1, 1), a1 + hstep, voffA);
            PG8_WAIT_L(8); PG8_BAR; PG8_WAIT_L(0); PG8_MMA(0, 0, At, B0); PG8_BAR; PG8_SCHED;
            PG8_LDB(B1, 0, 1); PG8_STAGE(PG8_SB(0, 0), b2, voffB);
            PG8_BAR; PG8_WAIT_L(0); PG8_MMA(0, 1, At, B1); PG8_BAR;
            PG8_LDA(At, 0, 1); PG8_STAGE(PG8_SA(0, 0), a2, voffA);
            PG8_BAR; PG8_WAIT_L(0); PG8_MMA(1, 0, At, B0); PG8_BAR; PG8_SCHED;
            PG8_STAGE(PG8_SB(0, 1), b2 + hstep, voffB);
            PG8_WAIT_V(6); PG8_BAR; PG8_MMA(1, 1, At, B1); PG8_BAR;
            PG8_LDB(B0, 1, 0); PG8_SCHED; PG8_LDA(At, 1, 0); PG8_STAGE(PG8_SA(0, 1), a2 + hstep, voffA);
            PG8_WAIT_L(8); PG8_BAR; PG8_WAIT_L(0); PG8_MMA(0, 0, At, B0); PG8_BAR; PG8_SCHED;
            PG8_LDB(B1, 1, 1); PG8_STAGE(PG8_SB(1, 0), b3, voffB);
            PG8_BAR; PG8_WAIT_L(0); PG8_MMA(0, 1, At, B1); PG8_BAR;
            PG8_LDA(At, 1, 1); PG8_STAGE(PG8_SA(1, 0), a3, voffA);
            PG8_BAR; PG8_WAIT_L(0); PG8_MMA(1, 0, At, B0); PG8_BAR; PG8_SCHED;
            PG8_STAGE(PG8_SB(1, 1), b3 + hstep, voffB);
            PG8_WAIT_V(6); PG8_BAR; PG8_MMA(1, 1, At, B1); PG8_BAR;
            }
        }
        if constexpr (ALIGN_EPI) { if (wr == 0) PG8_BAR; }
        if constexpr (!Epi::AFTER_DRAIN) { E(acc, cur, wr, wc, fr, fq); S.done(cur); }
        if (!has_next) break;
#pragma unroll
        for (int a = 0; a < 2; ++a)
#pragma unroll
            for (int b = 0; b < 2; ++b)
#pragma unroll
                for (int m = 0; m < 4; ++m)
#pragma unroll
                    for (int n = 0; n < 2; ++n) acc[a][b][m][n] = (f32x4){0.f, 0.f, 0.f, 0.f};
        cur = nxt; cA = nA; cB = nB; ++ui;
        if constexpr (ALIGN_EPI) { if (wr == 1) PG8_BAR; }
    }
    PG8_WAIT_V(0);
    if constexpr (!ALIGN_EPI) { if (wr == 0) PG8_BAR; }
    PG8_BAR;
    if constexpr (Epi::AFTER_DRAIN) { E.fused(acc, cur, wr, wc, fr, fq, lds, wid, lane); S.done(cur); }
#undef PG8_SA
#undef PG8_SB
#undef PG8_STAGE
#undef PG8_LDA
#undef PG8_LDB
#undef PG8_MMA
#undef PG8_WAIT_V
#undef PG8_WAIT_L
#undef PG8_BAR
#undef PG8_SCHED
}
}
#define LAS __attribute__((address_space(3)))
#define GAS __attribute__((address_space(1)))
typedef unsigned short bf16;
typedef unsigned v4u __attribute__((ext_vector_type(4)));
typedef unsigned v2u __attribute__((ext_vector_type(2)));
typedef float f32x4 __attribute__((ext_vector_type(4)));
typedef float f32x2 __attribute__((ext_vector_type(2)));
typedef short bf16x8 __attribute__((ext_vector_type(8)));
#define LDS_WAIT() asm volatile("s_waitcnt lgkmcnt(0)" ::: "memory")

#define XB_TMO      128
#define XB_XCNT(j)  (256  + 64 * (j))
#define XB_XSUB(j)  (1280 + 64 * (j))
#define XB_XGEN(j)  (2304 + 64 * (j))
#define XB_TOP      3328
#define XB_TOPGEN   3392
#define XCD_BAR_WORDS 3456
#define XB_SPIN_CAP (1u << 18)

__device__ __forceinline__ unsigned xb_ld(unsigned* p)              { return __hip_atomic_load(p, __ATOMIC_RELAXED, __HIP_MEMORY_SCOPE_AGENT); }
__device__ __forceinline__ unsigned xb_add(unsigned* p, unsigned v) { return __hip_atomic_fetch_add(p, v, __ATOMIC_RELAXED, __HIP_MEMORY_SCOPE_AGENT); }
__device__ __forceinline__ unsigned xb_xcc_id() { return (unsigned)__builtin_amdgcn_s_getreg((3 << 11) | 20) & 0xFu; }
#define XB_SPIN(cond, bar) do { unsigned _sp = 0; while (cond) { __builtin_amdgcn_s_sleep(1); \
    if ((++_sp & 255u) == 0u) { if (xb_ld(&(bar)[XB_TMO])) break; if (_sp > XB_SPIN_CAP) { atomicAdd(&(bar)[XB_TMO], 1u); break; } } } } while (0)

struct XcdBarrier {
    unsigned* bar; unsigned x;
    volatile LAS unsigned* st;
};

__device__ __forceinline__ XcdBarrier xcd_barrier_post(unsigned* bar, volatile LAS unsigned* st) {
    XcdBarrier b; b.bar = bar; b.x = xb_xcc_id(); b.st = st;
    if (threadIdx.x == 0) st[2] = xb_add(&bar[XB_XCNT(b.x)], 1u);
    return b;
}
__device__ __forceinline__ void xcd_barrier_complete(unsigned* bar, unsigned x, unsigned& nloc, unsigned& nx) {
    const unsigned G = gridDim.x * gridDim.y * gridDim.z;
    unsigned sum, cnt, mine, sp = 0u;
    for (;;) {
        sum = 0u; cnt = 0u; mine = 0u;
#pragma unroll
        for (unsigned j = 0; j < 16; ++j) { const unsigned c = xb_ld(&bar[XB_XCNT(j)]); sum += c; cnt += (c > 0u) ? 1u : 0u; mine = (j == x) ? c : mine; }
        if (sum == G) break;
        __builtin_amdgcn_s_sleep(1);
        if ((++sp & 255u) == 0u) { if (xb_ld(&bar[XB_TMO])) break; if (sp > XB_SPIN_CAP) { atomicAdd(&bar[XB_TMO], 1u); break; } }
    }
    nloc = mine > 0u ? mine : 1u; nx = cnt > 0u ? cnt : 1u;
}

__device__ __forceinline__ void xcd_barrier(const XcdBarrier& b) {
    asm volatile("s_waitcnt vmcnt(0)" ::: "memory");
    __syncthreads();
    if (threadIdx.x == 0) {
        unsigned* bar = b.bar;
        __builtin_amdgcn_s_waitcnt(0);
        unsigned nloc = b.st[0], nx = b.st[1];
        if (nloc == 0u) { xcd_barrier_complete(bar, b.x, nloc, nx); b.st[0] = nloc; b.st[1] = nx; }
        const unsigned old = xb_add(&bar[XB_XSUB(b.x)], 1u);
        const unsigned gen = old / nloc;
        if (old + 1u == (gen + 1u) * nloc) {
            __builtin_amdgcn_fence(__ATOMIC_RELEASE, "agent");
            asm volatile("s_waitcnt vmcnt(0)" ::: "memory");
            const unsigned og = xb_add(&bar[XB_TOP], 1u);
            const unsigned tg = og / nx;
            if (og + 1u == (tg + 1u) * nx) xb_add(&bar[XB_TOPGEN], 1u);
            else XB_SPIN(xb_ld(&bar[XB_TOPGEN]) == tg, bar);
            __builtin_amdgcn_fence(__ATOMIC_ACQUIRE, "agent");
            xb_add(&bar[XB_XGEN(b.x)], 1u);
            asm volatile("s_waitcnt vmcnt(0)" ::: "memory");
        } else {
            XB_SPIN(xb_ld(&bar[XB_XGEN(b.x)]) == gen, bar);
            __builtin_amdgcn_fence(__ATOMIC_ACQUIRE, "agent");
            asm volatile("s_waitcnt vmcnt(0)" ::: "memory");
        }
    }
    __syncthreads();
}

__device__ __forceinline__ void xcd_local_barrier(const XcdBarrier& b) {
    asm volatile("s_waitcnt vmcnt(0)" ::: "memory");
    __syncthreads();
    if (threadIdx.x == 0) {
        unsigned* bar = b.bar;
        __builtin_amdgcn_s_waitcnt(0);
        const unsigned nloc = b.st[0];
        const unsigned old = xb_add(&bar[XB_XSUB(b.x)], 1u);
        const unsigned gen = old / nloc;
        if (old + 1u == (gen + 1u) * nloc) xb_add(&bar[XB_XGEN(b.x)], 1u);
        else XB_SPIN(xb_ld(&bar[XB_XGEN(b.x)]) == gen, bar);
        __builtin_amdgcn_fence(__ATOMIC_ACQUIRE, "agent");
        asm volatile("s_waitcnt vmcnt(0)" ::: "memory");
    }
    __syncthreads();
}


#ifndef WGM_UP
#define WGM_UP PG8_WGM
#endif
#ifndef WGM_DN
#define WGM_DN PG8_WGM
#endif
#ifndef GP_ALIGN
#define GP_ALIGN true
#endif
#ifndef GP_SP2
#define GP_SP2 true
#endif
#ifndef S5_FAST
#define S5_FAST 1
#endif
#ifndef ONE_LAUNCH
#define ONE_LAUNCH 1
#endif

constexpr int NWAVES = 8;
constexpr int M = 16384, D = 2048, FF = 5632, DSSM = 1024, DG = 1024, DIN = 3072, DPLE = 256, SEQ = 4096;
constexpr float EPS = 1e-6f;
constexpr size_t MiB = 1u << 20;
constexpr size_t WS_W1GU = 1 * MiB, WS_W1D = 45 * MiB, WS_WIN = 67 * MiB, WS_WGLU = 79 * MiB, WS_WO = 81 * MiB, WS_W2GU = 89 * MiB, WS_W2D = 133 * MiB,
                 WS_WPG = 155 * MiB, WS_WPP = 163 * MiB, WS_S5W1 = 164 * MiB, WS_S5W3 = 168 * MiB, WS_S5C = 180 * MiB, WS_HPA = 181 * MiB, WS_HPB = 183 * MiB, WS_LNP = 185 * MiB,
                 WS_SSP = 187 * MiB, WS_GSP = 188 * MiB, WS_PB = 189 * MiB, WS_HB = 197 * MiB, WS_ACT = 261 * MiB, WS_ZS = 261 * MiB, WS_GV = 293 * MiB,
                 WS_YG = 325 * MiB, WS_YCAT = 357 * MiB  , WS_PP = 437 * MiB, WS_END = 501 * MiB;
constexpr int RING_BYTES = 131072, LDS_BYTES = 163840, MISC_OFF = LDS_BYTES - 256;
constexpr int S5_IMG_BYTES = 144 * 1024;

__device__ __forceinline__ unsigned f2bf(float f) { unsigned u = __builtin_bit_cast(unsigned, f); return (u + 0x7fffu + ((u >> 16) & 1u)) >> 16; }
__device__ __forceinline__ unsigned pk2(float lo, float hi) { return f2bf(lo) | (f2bf(hi) << 16); }
__device__ __forceinline__ float bflo(unsigned w) { return __uint_as_float(w << 16); }
__device__ __forceinline__ float bfhi(unsigned w) { return __uint_as_float(w & 0xffff0000u); }
__device__ __forceinline__ float wave_sum(float v) {
#pragma unroll
    for (int o = 1; o < 64; o <<= 1) v += __shfl_xor(v, o);
    return v;
}

struct Args { const float* in[31]; float* out; unsigned char* ws; int ph_lo, ph_hi; };
#define KARG_PTR(T, i) (((T const volatile __attribute__((address_space(4)))*)__builtin_amdgcn_kernarg_segment_ptr())[i])
#define INP(i) KARG_PTR(const float*, i)
#define OUTP() KARG_PTR(float*, 31)
#define WSP() KARG_PTR(unsigned char*, 32)
#define KARG_INT(i) KARG_PTR(int, i)
static_assert(sizeof(Args) == 33 * 8 + 8, "Args has no padding");

__device__ __forceinline__ void p0_transpose_item(const float* W, int K, int N, bf16* WT, const float* gain, int map, LAS float* scr, int item, int lane, int ldk = 0) {
    if (ldk == 0) ldk = K;
    const int nblk = N / 32, kb = item / nblk, nb = item % nblk, k0 = 64 * kb, n0 = 32 * nb;
#pragma unroll 8
    for (int i = 0; i < 32; ++i) { const int kk = 2 * i + (lane >> 5); scr[kk * 33 + (lane & 31)] = W[(size_t)(k0 + kk) * N + n0 + (lane & 31)]; }
    LDS_WAIT(); asm volatile("" ::: "memory");
    const int c = lane & 7;
    float gk[8];
#pragma unroll
    for (int e = 0; e < 8; ++e) gk[e] = gain ? gain[k0 + 8 * c + e] : 1.0f;
#pragma unroll
    for (int j = 0; j < 4; ++j) { const int nl = (lane >> 3) + 8 * j; const int n = n0 + nl; const LAS float* s = scr + (8 * c) * 33 + nl;
        const int drow = map == 0 ? n : (256 * (n >> 7) + (n & 127) + (map == 2 ? 128 : 0));
        v4u o; o.x = pk2(s[0 * 33] * gk[0], s[1 * 33] * gk[1]); o.y = pk2(s[2 * 33] * gk[2], s[3 * 33] * gk[3]); o.z = pk2(s[4 * 33] * gk[4], s[5 * 33] * gk[5]); o.w = pk2(s[6 * 33] * gk[6], s[7 * 33] * gk[7]);
        *(v4u*)(WT + (size_t)drow * ldk + k0 + 8 * c) = o; }
    LDS_WAIT(); asm volatile("" ::: "memory");
}

__device__ __forceinline__ void s5_gen(const Args& a, int g, LAS float* L, int tid) {
    LAS float* Pr = L; LAS float* Pi = L + 21 * 64; LAS float* Bbr = L + 42 * 64; LAS float* Bbi = Bbr + 1024; LAS float* Kd = Bbi + 1024;
    const float* log_dt = INP(8); const float* a_re = INP(9); const float* a_im = INP(10); const float* b_re = INP(11); const float* b_im = INP(12);
    const float* c_re = INP(13); const float* c_im = INP(14); const float* dvec = INP(15);
    bf16* W1 = (bf16*)(WSP() + WS_S5W1 + (size_t)g * S5_IMG_BYTES); bf16* W3C = W1 + 64 * 512; bf16* W3T = W1 + 128 * 512; float* SC = (float*)(WSP() + WS_S5C) + (size_t)g * 640;
    LAS float* Cr = Kd + 4096; LAS float* Ci = Cr + 1024; LAS float* Zr = Ci + 1024; LAS float* Zi = Zr + 64;
    const double dt = exp((double)log_dt[g]);
    for (int idx = tid; idx < 21 * 64; idx += 512) {
        const int n = idx & 63, k = idx >> 6;
        const double lr = fmin((double)a_re[g * 64 + n], -1e-4), li = (double)a_im[g * 64 + n];
        const double kk = k <= 16 ? (double)k : (k == 17 ? 32.0 : (k == 18 ? 64.0 : (k == 19 ? 128.0 : 512.0)));
        const double mag = exp(lr * dt * kk), ang = li * dt * kk;
        Pr[k * 64 + n] = (float)(mag * cos(ang)); Pi[k * 64 + n] = (float)(mag * sin(ang));
    }
    if (tid < 64) {
        const int n = tid;
        const double lr = fmin((double)a_re[g * 64 + n], -1e-4), li = (double)a_im[g * 64 + n];
        const double mag = exp(lr * dt), ang = li * dt, abr = mag * cos(ang), abi = mag * sin(ang);
        const double xr = abr - 1.0, xi = abi, den = lr * lr + li * li;
        Zr[n] = (float)((xr * lr + xi * li) / den); Zi[n] = (float)((xi * lr - xr * li) / den);
    }
    for (int idx = tid; idx < 1024; idx += 512) { Cr[idx] = c_re[g * 1024 + idx]; Ci[idx] = c_im[g * 1024 + idx]; }
    __syncthreads();
    for (int idx = tid; idx < 1024; idx += 512) { const int n = idx >> 4; const float br = b_re[g * 1024 + idx], bi = b_im[g * 1024 + idx], zr = Zr[n], zi = Zi[n];
        Bbr[idx] = zr * br - zi * bi; Bbi[idx] = zr * bi + zi * br; }
    for (int idx = tid; idx < 640; idx += 512) { const int l = idx >> 7, ri = (idx >> 6) & 1, n = idx & 63, k = l == 0 ? 16 : 16 + l; SC[idx] = ri ? Pi[k * 64 + n] : Pr[k * 64 + n]; }
    __syncthreads();
    for (int idx = tid; idx < 4096; idx += 512) {
        const int d = idx >> 8, p = (idx >> 4) & 15, pq = idx & 15; float s = 0.f;
        for (int n = 0; n < 64; ++n) { const float pr = Pr[d * 64 + n], pi = Pi[d * 64 + n], br = Bbr[n * 16 + pq], bi = Bbi[n * 16 + pq];
            const float xr = pr * br - pi * bi, xi = pr * bi + pi * br; s += Cr[p * 64 + n] * xr - Ci[p * 64 + n] * xi; }
        Kd[idx] = s;
    }
    __syncthreads();
    for (int id = tid; id < 64 * 64; id += 512) {
        const int f = id >> 6, lane = id & 63, mt = f >> 3, ks = f & 7, q = lane >> 4, r = lane & 15, np = 16 * mt + r, n = np & 63, s = 2 * ks + (q >> 1);
        const float pr = Pr[(15 - s) * 64 + n], pi = Pi[(15 - s) * 64 + n]; float v[8];
#pragma unroll
        for (int e = 0; e < 8; ++e) { const int p = 8 * (q & 1) + e; const float br = Bbr[n * 16 + p], bi = Bbi[n * 16 + p]; v[e] = np < 64 ? (pr * br - pi * bi) : (pr * bi + pi * br); }
        v4u o; o.x = pk2(v[0], v[1]); o.y = pk2(v[2], v[3]); o.z = pk2(v[4], v[5]); o.w = pk2(v[6], v[7]);
        *(v4u*)(W1 + (size_t)id * 8) = o;
    }
    for (int id = tid; id < 64 * 64; id += 512) {
        const int f = id >> 6, lane = id & 63, t = f >> 2, ks = f & 3, q = lane >> 4, p = lane & 15; float v[8];
#pragma unroll
        for (int e = 0; e < 8; ++e) { const int mtp = 2 * ks + (e >> 2), j = e & 3, n = 16 * (mtp & 3) + 4 * q + j;
            const float cr = Cr[p * 64 + n], ci = Ci[p * 64 + n], pr = Pr[(t + 1) * 64 + n], pi = Pi[(t + 1) * 64 + n];
            v[e] = mtp < 4 ? (cr * pr - ci * pi) : -(cr * pi + ci * pr); }
        v4u o; o.x = pk2(v[0], v[1]); o.y = pk2(v[2], v[3]); o.z = pk2(v[4], v[5]); o.w = pk2(v[6], v[7]);
        *(v4u*)(W3C + (size_t)id * 8) = o;
    }
    for (int id = tid; id < 16 * 64; id += 512) {
        const int dl = id >> 6, lane = id & 63, q = lane >> 4, p = lane & 15, lag = dl - (q >> 1); float v[8];
#pragma unroll
        for (int e = 0; e < 8; ++e) { const int pq = 8 * (q & 1) + e; float x = 0.f; if (lag >= 0) x = Kd[(lag * 16 + p) * 16 + pq]; if (lag == 0 && pq == p) x += dvec[g * 16 + p]; v[e] = x; }
        v4u o; o.x = pk2(v[0], v[1]); o.y = pk2(v[2], v[3]); o.z = pk2(v[4], v[5]); o.w = pk2(v[6], v[7]);
        *(v4u*)(W3T + (size_t)id * 8) = o;
    }
    __syncthreads();
}

__device__ __forceinline__ void p0_prologue(const Args& a, LAS unsigned char* lds, int tid, int lane, int wave, int G) {
#ifndef S5GEN_REPS
#define S5GEN_REPS 1
#endif
    for (int rr = 0; rr < S5GEN_REPS; ++rr)
    for (int g = blockIdx.x; g < 64; g += G) s5_gen(a, g, (LAS float*)lds, tid);
    __syncthreads();
    LAS float* scr = (LAS float*)(lds + wave * 16384);
    const int gw = blockIdx.x * NWAVES + wave, NGW = G * NWAVES;
    unsigned char* ws = WSP();
    constexpr int I_GU = (D / 64) * (FF / 32), I_DN = (FF / 64) * (D / 32), I_IN = (D / 64) * (DIN / 32), I_GLU = (DSSM / 64) * (DSSM / 32), I_OH = (1024 / 64) * (D / 32), I_PG = (D / 64) * (D / 32), I_PP = (DPLE / 64) * (D / 32);
    constexpr int NITEMS = 4 * I_GU + 2 * I_DN + I_IN + I_GLU + 2 * I_OH + I_PG + I_PP;
#ifndef TR_REPS
#define TR_REPS 1
#endif
    for (int trr = 0; trr < TR_REPS; ++trr)
    for (int it = gw; it < NITEMS; it += NGW) {
        int r = it;
        if (r < I_GU) { p0_transpose_item(INP(3), D, FF, (bf16*)(ws + WS_W1GU), INP(2), 1, scr, r, lane); continue; } r -= I_GU;
        if (r < I_GU) { p0_transpose_item(INP(4), D, FF, (bf16*)(ws + WS_W1GU), INP(2), 2, scr, r, lane); continue; } r -= I_GU;
        if (r < I_DN) { p0_transpose_item(INP(5), FF, D, (bf16*)(ws + WS_W1D), nullptr, 0, scr, r, lane); continue; } r -= I_DN;
        if (r < I_IN) { p0_transpose_item(INP(7), D, DIN, (bf16*)(ws + WS_WIN), INP(6), 0, scr, r, lane); continue; } r -= I_IN;
        if (r < I_GLU) { p0_transpose_item(INP(16), DSSM, DSSM, (bf16*)(ws + WS_WGLU), nullptr, 0, scr, r, lane); continue; } r -= I_GLU;
        if (r < I_OH) { p0_transpose_item(INP(22), 1024, D, (bf16*)(ws + WS_WO), INP(20), 0, scr, r, lane, D); continue; } r -= I_OH;
        if (r < I_OH) { p0_transpose_item(INP(22) + (size_t)1024 * D, 1024, D, (bf16*)(ws + WS_WO) + 1024, INP(21), 0, scr, r, lane, D); continue; } r -= I_OH;
        if (r < I_GU) { p0_transpose_item(INP(24), D, FF, (bf16*)(ws + WS_W2GU), INP(23), 1, scr, r, lane); continue; } r -= I_GU;
        if (r < I_GU) { p0_transpose_item(INP(25), D, FF, (bf16*)(ws + WS_W2GU), INP(23), 2, scr, r, lane); continue; } r -= I_GU;
        if (r < I_DN) { p0_transpose_item(INP(26), FF, D, (bf16*)(ws + WS_W2D), nullptr, 0, scr, r, lane); continue; } r -= I_DN;
        if (r < I_PG) { p0_transpose_item(INP(28), D, D, (bf16*)(ws + WS_WPG), INP(27), 0, scr, r, lane); continue; } r -= I_PG;
        p0_transpose_item(INP(29), DPLE, D, (bf16*)(ws + WS_WPP), nullptr, 0, scr, r, lane);
    }
    const float* x = INP(0); bf16* xb = (bf16*)(ws + WS_HB); float* hpA = (float*)(ws + WS_HPA);
    const int nskip = (G > 128) ? 64 : 0;
    const int gw2 = ((int)blockIdx.x - nskip) * NWAVES + wave, NGW2 = (G - nskip) * NWAVES;
    if ((int)blockIdx.x >= nskip)
    for (int m = gw2; m < M; m += NGW2) {
        const f32x4* xr = (const f32x4*)(x + (size_t)m * D) + lane; float s = 0.f;
        unsigned long long* o8 = (unsigned long long*)(xb + (size_t)m * D) + lane;
#pragma unroll
        for (int j = 0; j < 8; ++j) { const f32x4 v = xr[64 * j]; s += (v[0] * v[0] + v[1] * v[1]) + (v[2] * v[2] + v[3] * v[3]);
            o8[64 * j] = (unsigned long long)pk2(v[0], v[1]) | ((unsigned long long)pk2(v[2], v[3]) << 32); }
        s = wave_sum(s);
        if (lane < 32) hpA[(size_t)m * 32 + lane] = lane == 0 ? s : 0.f;
    }
    const float* p = INP(1); bf16* pb = (bf16*)(ws + WS_PB);
    if ((int)blockIdx.x >= nskip)
    for (size_t i = (size_t)gw2 * 64 + lane; i < (size_t)M * DPLE / 4; i += (size_t)NGW2 * 64) { const f32x4 v = ((const f32x4*)p)[i];
        ((unsigned long long*)pb)[i] = (unsigned long long)pk2(v[0], v[1]) | ((unsigned long long)pk2(v[2], v[3]) << 32); }
}

__device__ __forceinline__ void gmlp_phase(const Args& a, LAS unsigned char* lds, int tid, int lane, int wave, int G) {
    constexpr int VP = 136;
    LAS bf16* LV = (LAS bf16*)lds; LAS bf16* LW = (LAS bf16*)(lds + 128 * VP * 2); LAS float* ST = (LAS float*)(lds + 2 * 128 * VP * 2);
    unsigned char* ws = WSP();
    const bf16* gv = (const bf16*)(ws + WS_GV); bf16* gu = (bf16*)(ws + WS_YCAT) + 1024;     const float* lnp = (const float*)(ws + WS_LNP); float* gsp = (float*)(ws + WS_GSP);
    const float* normv = INP(17); const float* w_s = INP(18); const float* b_s = INP(19);
    const int fr = lane & 15, q = lane >> 4;
    int h_staged = -1;
    for (int unit = blockIdx.x; unit < 1024; unit += G) {
        const int h = unit & 7, m0 = (unit >> 3) * 128;
        if (tid < 128) { const f32x4* pp = (const f32x4*)(lnp + (size_t)(m0 + tid) * 32); float s1 = 0.f, s2 = 0.f;
#pragma unroll
            for (int i = 0; i < 8; ++i) { const f32x4 v = pp[i]; s1 += v[0] + v[2]; s2 += v[1] + v[3]; }
            const float mean = s1 * (1.0f / 1024.0f), var = s2 * (1.0f / 1024.0f) - mean * mean;
            ST[2 * tid] = mean; ST[2 * tid + 1] = rsqrtf(fmaxf(var, 0.f) + EPS); }
        __syncthreads();
#pragma unroll
        for (int i = 0; i < 2; ++i) { const int id = tid + 512 * i, s = 2 * (id >> 4), pc = id & 15;
            const v4u w0 = *(const v4u*)(gv + (size_t)(m0 + s) * 1024 + h * 128 + pc * 8), w1 = *(const v4u*)(gv + (size_t)(m0 + s + 1) * 1024 + h * 128 + pc * 8);
            const float mean0 = ST[2 * s], rstd0 = ST[2 * s + 1], mean1 = ST[2 * s + 2], rstd1 = ST[2 * s + 3];
            const f32x4 g0 = *(const f32x4*)(normv + h * 128 + pc * 8), g1 = *(const f32x4*)(normv + h * 128 + pc * 8 + 4);
            const float v0[8] = {bflo(w0.x), bfhi(w0.x), bflo(w0.y), bfhi(w0.y), bflo(w0.z), bfhi(w0.z), bflo(w0.w), bfhi(w0.w)};
            const float v1[8] = {bflo(w1.x), bfhi(w1.x), bflo(w1.y), bfhi(w1.y), bflo(w1.z), bfhi(w1.z), bflo(w1.w), bfhi(w1.w)};
#pragma unroll
            for (int e = 0; e < 8; ++e) { const float gg = e < 4 ? g0[e & 3] : g1[e & 3];
                *(LAS unsigned*)(LV + (pc * 8 + e) * VP + s) = pk2((v0[e] - mean0) * rstd0 * gg, (v1[e] - mean1) * rstd1 * gg); } }
        if (h != h_staged) { h_staged = h;
#pragma unroll
        for (int i = 0; i < 8; ++i) { const int id = tid + 512 * i, t = id >> 5, sc = id & 31;
            const f32x4 w = *(const f32x4*)(w_s + ((size_t)h * 128 + t) * 128 + sc * 4);
            float v[4];
#pragma unroll
            for (int e = 0; e < 4; ++e) v[e] = (sc * 4 + e <= t) ? w[e] : 0.f;
            *(LAS v2u*)(LW + t * VP + sc * 4) = (v2u){pk2(v[0], v[1]), pk2(v[2], v[3])}; }
        }
        __syncthreads();
        f32x4 acc[8];
#pragma unroll
        for (int pt = 0; pt < 8; ++pt) acc[pt] = (f32x4){0.f, 0.f, 0.f, 0.f};
        const int nks = (16 * wave + 15) / 32 + 1;
        for (int ks = 0; ks < nks; ++ks) {
            const bf16x8 wf = *(const LAS bf16x8*)(LW + (16 * wave + fr) * VP + ks * 32 + 8 * q);
#pragma unroll
            for (int pt = 0; pt < 8; ++pt) { const bf16x8 vf = *(const LAS bf16x8*)(LV + (16 * pt + fr) * VP + ks * 32 + 8 * q);
                acc[pt] = __builtin_amdgcn_mfma_f32_16x16x32_bf16(vf, wf, acc[pt], 0, 0, 0); }
        }
        const int t = 16 * wave + fr, row = m0 + t; const float bias = b_s[h * 128 + t]; float ss = 0.f;
#pragma unroll
        for (int pt = 0; pt < 8; ++pt) { bf16* gp = gu + (size_t)row * 2048 + h * 128 + 16 * pt + 4 * q; const v2u w = *(const v2u*)gp;
            const float o0 = bflo(w.x) * (acc[pt][0] + bias), o1 = bfhi(w.x) * (acc[pt][1] + bias), o2 = bflo(w.y) * (acc[pt][2] + bias), o3 = bfhi(w.y) * (acc[pt][3] + bias);
            ss += (o0 * o0 + o1 * o1) + (o2 * o2 + o3 * o3);
            *(v2u*)gp = (v2u){pk2(o0, o1), pk2(o2, o3)}; }
        ss += __shfl_xor(ss, 16); ss += __shfl_xor(ss, 32);
        if (q == 0) gsp[(size_t)row * 8 + h] = ss;
        __syncthreads();
    }
}

#if !S5_FAST
__device__ __forceinline__ void s5_phase(const Args& a, LAS unsigned char* lds, int tid, int lane, int wave, int G) {
    unsigned char* ws = WSP(); const bf16* zs = (const bf16*)(ws + WS_ZS); bf16* yg = (bf16*)(ws + WS_YG);
    const float* log_dt = INP(8); const float* a_re = INP(9); const float* a_im = INP(10); const float* b_re = INP(11); const float* b_im = INP(12);
    const float* c_re = INP(13); const float* c_im = INP(14); const float* dvec = INP(15);
    for (int job = blockIdx.x * NWAVES + wave; job < 256; job += G * NWAVES) {
        const int b = job >> 6, g = job & 63, n = lane;
        const float dt = expf(log_dt[g]), lr = fminf(a_re[g * 64 + n], -1e-4f), li = a_im[g * 64 + n];
        const float mag = expf(lr * dt), ang = li * dt, abr = mag * cosf(ang), abi = mag * sinf(ang);
        const float xr = abr - 1.0f, xi = abi, den = lr * lr + li * li, zr = (xr * lr + xi * li) / den, zi = (xi * lr - xr * li) / den;
        float bbr[16], bbi[16], cr[16], ci[16];
#pragma unroll
        for (int p = 0; p < 16; ++p) { const float br = b_re[(g * 64 + n) * 16 + p], bi = b_im[(g * 64 + n) * 16 + p]; bbr[p] = zr * br - zi * bi; bbi[p] = zr * bi + zi * br;
            cr[p] = c_re[(g * 16 + p) * 64 + n]; ci[p] = c_im[(g * 16 + p) * 64 + n]; }
        float sr = 0.f, si = 0.f;
        for (int t = 0; t < SEQ; ++t) {
            const size_t row = (size_t)b * SEQ + t;
            const v4u u0 = *(const v4u*)(zs + row * 1024 + 16 * g), u1 = *(const v4u*)(zs + row * 1024 + 16 * g + 8);
            const float uu[16] = {bflo(u0.x), bfhi(u0.x), bflo(u0.y), bfhi(u0.y), bflo(u0.z), bfhi(u0.z), bflo(u0.w), bfhi(u0.w), bflo(u1.x), bfhi(u1.x), bflo(u1.y), bfhi(u1.y), bflo(u1.z), bfhi(u1.z), bflo(u1.w), bfhi(u1.w)};
            float dr = 0.f, di = 0.f;
#pragma unroll
            for (int p = 0; p < 16; ++p) { dr += bbr[p] * uu[p]; di += bbi[p] * uu[p]; }
            const float nsr = abr * sr - abi * si + dr, nsi = abr * si + abi * sr + di; sr = nsr; si = nsi;
            float y[16];
#pragma unroll
            for (int p = 0; p < 16; ++p) { float v = wave_sum(cr[p] * sr - ci[p] * si); v += dvec[g * 16 + p] * uu[p]; y[p] = pg8::gelu_tanh(v); }
            if (lane == 0) { v4u o0, o1; o0.x = pk2(y[0], y[1]); o0.y = pk2(y[2], y[3]); o0.z = pk2(y[4], y[5]); o0.w = pk2(y[6], y[7]); o1.x = pk2(y[8], y[9]); o1.y = pk2(y[10], y[11]); o1.z = pk2(y[12], y[13]); o1.w = pk2(y[14], y[15]);
                *(v4u*)(yg + row * 1024 + 16 * g) = o0; *(v4u*)(yg + row * 1024 + 16 * g + 8) = o1; }
        }
    }
}
#else
template <int N> __device__ __forceinline__ float dpp_shr(float v) { return __int_as_float(__builtin_amdgcn_update_dpp(0, __float_as_int(v), 0x110 + N, 0xF, 0xF, true)); }

template <bool DO_Y> __device__ __forceinline__ void s5_superblock(const bf16* zs, bf16* yg, const LAS unsigned char* img, const LAS float* CST, LAS float* scp, size_t t0, int g, int lane, GAS f32x4* ebuf) {
    const int fr = lane & 15, q = lane >> 4;
    f32x4 E[8];
    if constexpr (!DO_Y) {
        bf16x8 U[8];
#pragma unroll
        for (int ks = 0; ks < 8; ++ks) U[ks] = *(const GAS bf16x8*)(zs + (t0 + 16 * fr + 2 * ks + (q >> 1)) * 1024 + 16 * g + 8 * (q & 1));
        const LAS bf16x8* w1p = (const LAS bf16x8*)(img + lane * 16);
#pragma unroll
        for (int mt = 0; mt < 8; ++mt) {
            E[mt] = (f32x4){0.f, 0.f, 0.f, 0.f};
#pragma unroll
            for (int ks = 0; ks < 8; ++ks) E[mt] = __builtin_amdgcn_mfma_f32_16x16x32_bf16(w1p[64 * (mt * 8 + ks)], U[ks], E[mt], 0, 0, 0);
            ebuf[64 * mt + lane] = E[mt];
            asm volatile("" ::: "memory");
        }
    } else {
#pragma unroll
        for (int mt = 0; mt < 8; ++mt) E[mt] = ebuf[64 * mt + lane];
    }
#pragma unroll
    for (int mt = 0; mt < 4; ++mt) { const f32x4 mr = *(const LAS f32x4*)(CST + 0 * 64 + 16 * mt + 4 * q), mi = *(const LAS f32x4*)(CST + 1 * 64 + 16 * mt + 4 * q);
        const f32x4 cr = *(const LAS f32x4*)(scp + 16 * mt + 4 * q), ci = *(const LAS f32x4*)(scp + 16 * (mt + 4) + 4 * q);
        if (fr == 0) { E[mt] += mr * cr - mi * ci; E[mt + 4] += mr * ci + mi * cr; } }
#define S5_LEVEL(LV, DD) { \
    _Pragma("unroll") for (int mt = 0; mt < 4; ++mt) { const f32x4 mr = *(const LAS f32x4*)(CST + ((LV) * 2 + 0) * 64 + 16 * mt + 4 * q), mi = *(const LAS f32x4*)(CST + ((LV) * 2 + 1) * 64 + 16 * mt + 4 * q); \
        _Pragma("unroll") for (int j = 0; j < 4; ++j) { const float sr = dpp_shr<DD>(E[mt][j]), si = dpp_shr<DD>(E[mt + 4][j]); \
            E[mt][j] += mr[j] * sr - mi[j] * si; E[mt + 4][j] += mr[j] * si + mi[j] * sr; } } }
    __builtin_amdgcn_sched_barrier(0); S5_LEVEL(0, 1) __builtin_amdgcn_sched_barrier(0); S5_LEVEL(1, 2) __builtin_amdgcn_sched_barrier(0); S5_LEVEL(2, 4) __builtin_amdgcn_sched_barrier(0); S5_LEVEL(3, 8) __builtin_amdgcn_sched_barrier(0);
#undef S5_LEVEL
    bf16x8 Sb[4];
    if constexpr (DO_Y) {
#pragma unroll
        for (int ks = 0; ks < 4; ++ks) { float x[8];
#pragma unroll
            for (int h = 0; h < 2; ++h) { const f32x4 c = *(const LAS f32x4*)(scp + 16 * (2 * ks + h) + 4 * q);
#pragma unroll
                for (int j = 0; j < 4; ++j) { const float sh = dpp_shr<1>(E[2 * ks + h][j]); x[4 * h + j] = fr == 0 ? c[j] : sh; } }
            v4u w; w.x = pg8::cvt_pk_bf16(x[0], x[1]); w.y = pg8::cvt_pk_bf16(x[2], x[3]); w.z = pg8::cvt_pk_bf16(x[4], x[5]); w.w = pg8::cvt_pk_bf16(x[6], x[7]);
            Sb[ks] = __builtin_bit_cast(bf16x8, w); }
    }
    asm volatile("s_waitcnt lgkmcnt(0)" ::: "memory");
    if (fr == 15) {
#pragma unroll
        for (int mt = 0; mt < 8; ++mt) *(LAS f32x4*)(scp + 16 * mt + 4 * q) = E[mt]; }
    if constexpr (DO_Y) {
        asm volatile("" ::: "memory");
        bf16x8 U2[8];
#pragma unroll
        for (int ks = 0; ks < 8; ++ks) U2[ks] = *(const GAS bf16x8*)(zs + (t0 + 16 * fr + 2 * ks + (q >> 1)) * 1024 + 16 * g + 8 * (q & 1));
        const LAS bf16x8* w3c = (const LAS bf16x8*)(img + 65536 + lane * 16);
        const LAS bf16x8* w3t = (const LAS bf16x8*)(img + 131072 + lane * 16);
        GAS v2u* yp = (GAS v2u*)(yg + (t0 + 16 * fr) * 1024 + 16 * g + 4 * q);
#pragma unroll
        for (int mt = 0; mt < 16; ++mt) {
            f32x4 acc = (f32x4){0.f, 0.f, 0.f, 0.f};
#pragma unroll
            for (int ks = 0; ks < 4; ++ks) acc = __builtin_amdgcn_mfma_f32_16x16x32_bf16(w3c[64 * (4 * mt + ks)], Sb[ks], acc, 0, 0, 0);
#pragma unroll
            for (int ks = 0; ks <= mt / 2; ++ks) acc = __builtin_amdgcn_mfma_f32_16x16x32_bf16(w3t[64 * (mt - 2 * ks)], U2[ks], acc, 0, 0, 0);
            const float y0 = pg8::gelu_tanh(acc[0]), y1 = pg8::gelu_tanh(acc[1]), y2 = pg8::gelu_tanh(acc[2]), y3 = pg8::gelu_tanh(acc[3]);
            yp[256 * mt] = (v2u){pg8::cvt_pk_bf16(y0, y1), pg8::cvt_pk_bf16(y2, y3)};
            asm volatile("" ::: "memory");
        }
    }
}

__device__ __forceinline__ void s5_fill_image(const unsigned char* ws, LAS unsigned char* lds, int g, int tid) {
    const GAS v4u* src = (const GAS v4u*)(ws + WS_S5W1 + (size_t)g * S5_IMG_BYTES) + tid; LAS v4u* dst = (LAS v4u*)lds + tid;
#pragma unroll 6
    for (int i = 0; i < S5_IMG_BYTES / 16 / 512; ++i) dst[512 * i] = src[512 * i];
}
__device__ __forceinline__ void s5_phase(const Args& a, LAS unsigned char* lds, int tid, int lane, int wave, int G, bool prefetched) {
    unsigned char* ws = WSP(); const bf16* zs = (const bf16*)(ws + WS_ZS); bf16* yg = (bf16*)(ws + WS_YG);
    LAS float* CST = (LAS float*)(lds + S5_IMG_BYTES); LAS float* ESEG = CST + 640; LAS float* SCW = ESEG + 1024;
    static_assert(S5_IMG_BYTES + (640 + 2048) * 4 <= MISC_OFF, "S5 LDS map");
    const int q = lane >> 4, fr = lane & 15;
    for (int job = blockIdx.x; job < 256; job += G) {
        const int b = job >> 6, g = job & 63;
        const float* SC = (const float*)(ws + WS_S5C) + (size_t)g * 640;
        for (int i = tid; i < 640; i += 512) CST[i] = SC[i];
        if (!(prefetched && job == (int)blockIdx.x)) s5_fill_image(ws, lds, g, tid);
        LAS float* eseg = ESEG + wave * 128; LAS float* scw = SCW + wave * 128;
        eseg[lane] = 0.f; eseg[64 + lane] = 0.f;
        __syncthreads();
        const size_t tb = (size_t)b * SEQ + 512 * wave;
        GAS f32x4* ebase = (GAS f32x4*)(ws + WS_HB) + ((size_t)job * NWAVES + wave) * 1024;
#ifndef NO_PASSA
#pragma unroll 1
        for (int sb = 0; sb < 2; ++sb) s5_superblock<false>(zs, yg, lds, CST, eseg, tb + 256 * sb, g, lane, ebase + 512 * sb);
#endif
        __syncthreads();
        if (fr == 0) {
            f32x4 sr[4], si[4];
#pragma unroll
            for (int mt = 0; mt < 4; ++mt) { sr[mt] = (f32x4){0.f, 0.f, 0.f, 0.f}; si[mt] = (f32x4){0.f, 0.f, 0.f, 0.f}; }
            for (int w2 = 0; w2 < wave; ++w2) {
#pragma unroll
                for (int mt = 0; mt < 4; ++mt) { const f32x4 mr = *(const LAS f32x4*)(CST + 8 * 64 + 16 * mt + 4 * q), mi = *(const LAS f32x4*)(CST + 9 * 64 + 16 * mt + 4 * q);
                    const f32x4 er = *(const LAS f32x4*)(ESEG + w2 * 128 + 16 * mt + 4 * q), ei = *(const LAS f32x4*)(ESEG + w2 * 128 + 16 * (mt + 4) + 4 * q);
                    const f32x4 nr = mr * sr[mt] - mi * si[mt] + er, ni = mr * si[mt] + mi * sr[mt] + ei; sr[mt] = nr; si[mt] = ni; }
            }
#pragma unroll
            for (int mt = 0; mt < 4; ++mt) { *(LAS f32x4*)(scw + 16 * mt + 4 * q) = sr[mt]; *(LAS f32x4*)(scw + 16 * (mt + 4) + 4 * q) = si[mt]; }
        }
#ifndef NO_PASSC
#pragma unroll 1
        for (int sb = 0; sb < 2; ++sb) s5_superblock<true>(zs, yg, lds, CST, scw, tb + 256 * sb, g, lane, ebase + 512 * sb);
#endif
        __syncthreads();
    }
}
#endif

__device__ __forceinline__ void final_phase(const Args& a, int lane, int wave, int G, int c_x, bool loc_ok) {
    const float* hp = (const float*)(WSP() + WS_HPA); const float* gf = INP(30); float* out = OUTP();
    const int nw = loc_ok ? (G / 8) * NWAVES : G * NWAVES, w0 = loc_ok ? (c_x >> 3) * NWAVES + wave : (int)blockIdx.x * NWAVES + wave;
    const int mbase = loc_ok ? (c_x & 7) * (M / 8) : 0, mcnt = loc_ok ? M / 8 : M;
    for (int mi = w0; mi < mcnt; mi += nw) {
        const int m = mbase + mi;
        float s = lane < 32 ? hp[(size_t)m * 32 + lane] : 0.f; s = wave_sum(s);
        const float r = rsqrtf(s * (1.0f / 2048.0f) + EPS);
        f32x4* o = (f32x4*)(out + (size_t)m * D) + lane; const f32x4* gg = (const f32x4*)gf + lane;
#pragma unroll
        for (int j = 0; j < 8; ++j) { const f32x4 v = o[64 * j], w = gg[64 * j]; o[64 * j] = v * r * w; }
    }
}

constexpr int N_PHASES = 12;
__global__ void __launch_bounds__(NWAVES * 64, 2) fwd_kernel(Args args) {
    extern __shared__ __attribute__((aligned(16))) unsigned char lds_raw[];
    LAS unsigned char* lds = (LAS unsigned char*)lds_raw;
    const int tid = threadIdx.x, lane = tid & 63, wave = __builtin_amdgcn_readfirstlane(tid >> 6), G = gridDim.x, c = blockIdx.x;
    unsigned char* ws = WSP();
    const int lo = KARG_INT(66), hi = KARG_INT(67);
    cg::grid_group grid = cg::this_grid();
    volatile LAS unsigned* MISC = (volatile LAS unsigned*)(lds + MISC_OFF);
    if (tid < 16) MISC[tid] = 0u;
    __syncthreads();
    unsigned* barw = (unsigned*)(WSP() + 16384);
    XcdBarrier bar; bar.bar = barw; bar.x = 0; bar.st = nullptr;
#ifndef PHMASK
#define PHMASK 0xFFFF
#endif
#define IN(k) (((PHMASK >> (k)) & 1) && lo <= (k) && (k) < hi)
#define SEAM(k) do { if (IN(k) && IN((k) + 1)) xcd_barrier(bar); } while (0)
#define SEAM_L(k) do { if (IN(k) && IN((k) + 1)) { if (loc_ok) xcd_local_barrier(bar); else xcd_barrier(bar); } } while (0)
#ifndef REPMASK
#define REPMASK 0
#endif
#define REP(k) ((REPMASK >> (k)) & 1)
#ifndef EXTRA_SYNCS
#define EXTRA_SYNCS 0
#endif
    bf16* hb = (bf16*)(ws + WS_HB); bf16* act = (bf16*)(ws + WS_ACT); float* hpA = (float*)(ws + WS_HPA); float* hpB = (float*)(ws + WS_HPB);
    bf16* ppb = (bf16*)(ws + WS_PP);

    for (int i = 0; i < EXTRA_SYNCS; ++i) grid.sync();
    bool s5_pref = false;
    for (int rep = 0; rep <= REP(0); ++rep) { if (rep) grid.sync();
    if (IN(0)) { if (blockIdx.x == 0) for (int i = tid; i < XCD_BAR_WORDS; i += NWAVES * 64) barw[i] = 0u;
        p0_prologue(args, lds, tid, lane, wave, G); } }
    int c_x = c; bool loc_ok = false;
    if (IN(0) && IN(1)) { grid.sync(); bar = xcd_barrier_post(barw, MISC + 8);
        if (tid == 0) { unsigned nloc, nx; xcd_barrier_complete(barw, bar.x, nloc, nx); MISC[8] = nloc; MISC[9] = nx; }
        __syncthreads();
        bool ok = (G % 8 == 0);
#pragma unroll
        for (unsigned j = 0; j < 16; ++j) { const unsigned cn = xb_ld(&barw[XB_XCNT(j)]); ok = ok && (cn == (j < 8 ? (unsigned)G / 8u : 0u)); }
        const unsigned rank = MISC[10];
#ifndef NO_LOCAL_SEAMS
        const int okf = __builtin_amdgcn_readfirstlane((ok && rank < (unsigned)G / 8u && MISC[8] == (unsigned)G / 8u) ? 1 : 0);
        if (okf) { c_x = __builtin_amdgcn_readfirstlane((int)(bar.x + 8u * rank)); loc_ok = true; }
#endif
    }
    for (int rep = 0; rep <= REP(1); ++rep) { if (rep) grid.sync();
    if (IN(1)) {
        { pg8::Gemm g{(const bf16*)(ws + WS_PB), (const bf16*)(ws + WS_WPP), M, D, DPLE}; pg8::StaticOrder S; S.init(M, D, G, c_x); pg8::EpiPlain E{ppb, D};
          pg8::gemm_phase<pg8::EpiPlain, pg8::StaticOrder, GP_ALIGN, GP_SP2>(lds, g, S, E); }
        { pg8::Gemm g{hb, (const bf16*)(ws + WS_W1GU), M, 2 * FF, D}; pg8::StaticOrder S; S.init(M, 2 * FF, G, c_x, WGM_UP); pg8::EpiSwiglu E{act, hpA, FF};
          pg8::gemm_phase<pg8::EpiSwiglu, pg8::StaticOrder, GP_ALIGN, GP_SP2>(lds, g, S, E); }
    } }
    SEAM_L(1);
    for (int rep = 0; rep <= REP(2); ++rep) { if (rep) grid.sync();
    if (IN(2)) {
        pg8::Gemm g{act, (const bf16*)(ws + WS_W1D), M, D, FF}; pg8::StaticOrder S; S.init(M, D, G, c_x, WGM_DN);
        pg8::EpiRes<0, false, true, true> E{INP(0), OUTP(), hb, hpB, nullptr, nullptr, 0.5f, 0.f};
        pg8::gemm_phase<pg8::EpiRes<0, false, true, true>, pg8::StaticOrder, GP_ALIGN, GP_SP2>(lds, g, S, E);
    } }
    SEAM(2);
    if (IN(3)) {
        pg8::Gemm g{hb, (const bf16*)(ws + WS_WIN), M, DIN, D}; pg8::StaticOrder S; S.init(M, DIN, G, c_x);
        pg8::EpiWin E{(bf16*)(ws + WS_ZS), (WS_YCAT - WS_ZS) / 2 + 1024, (WS_GV - WS_ZS) / 2, (float*)(ws + WS_LNP), hpB};
        pg8::gemm_phase<pg8::EpiWin, pg8::StaticOrder, GP_ALIGN, GP_SP2>(lds, g, S, E);
#if S5_FAST
        if (IN(4) && (int)blockIdx.x < 256) { s5_fill_image(ws, lds, (int)blockIdx.x & 63, tid); s5_pref = true; }
#endif
    }
    SEAM(3);
    if (IN(4)) { for (int rep = 0; rep <= REP(4); ++rep) { s5_phase(args, lds, tid, lane, wave, G, s5_pref && rep == 0); __syncthreads(); }
#ifndef NO_GMLP
 gmlp_phase(args, lds, tid, lane, wave, G);
#endif
 }
    SEAM(4);
    if (IN(5)) {
        pg8::Gemm g{(const bf16*)(ws + WS_YG), (const bf16*)(ws + WS_WGLU), M, DSSM, DSSM}; pg8::StaticOrder S; S.init(M, DSSM, G, c_x);
        pg8::EpiGlu E{(const bf16*)(ws + WS_YG), (bf16*)(ws + WS_YCAT), (float*)(ws + WS_SSP)};
        pg8::gemm_phase<pg8::EpiGlu, pg8::StaticOrder, GP_ALIGN, GP_SP2>(lds, g, S, E);
    }
    SEAM_L(5);
    if (IN(6)) {
        LAS float* midtab = (LAS float*)(lds + RING_BYTES);
        pg8::StaticOrder S; S.init(M, D, G, c_x);
        { const float* ssp = (const float*)(ws + WS_SSP); const float* gsp = (const float*)(ws + WS_GSP);
          for (int i = tid >> 8; i < 8; i += 2) { pg8::Unit u; if (!S.next(i, u)) break; const int row = u.pm * 256 + (tid & 255);
              const f32x4* sp = (const f32x4*)(ssp + (size_t)row * 16); const f32x4* gp = (const f32x4*)(gsp + (size_t)row * 8); float ssum = 0.f, gsum = 0.f;
#pragma unroll
              for (int j = 0; j < 4; ++j) { const f32x4 v = sp[j]; ssum += (v[0] + v[1]) + (v[2] + v[3]); }
#pragma unroll
              for (int j = 0; j < 2; ++j) { const f32x4 v = gp[j]; gsum += (v[0] + v[1]) + (v[2] + v[3]); }
              midtab[i * 256 + (tid & 255)] = sqrtf((gsum * (1.0f / 1024.0f) + EPS) / (ssum * (1.0f / 1024.0f) + EPS)); }
          __syncthreads(); }
        pg8::Gemm g{(const bf16*)(ws + WS_YCAT), (const bf16*)(ws + WS_WO), M, D, D};
        pg8::EpiRes<8, false, true, true> E{OUTP(), OUTP(), hb, hpA, (const float*)(ws + WS_GSP), nullptr, 0.f, 1.0f / 1024.0f};
        pg8::gemm_phase<pg8::EpiRes<8, false, true, true>, pg8::StaticOrder, GP_ALIGN, GP_SP2, true>(lds, g, S, E, midtab);
    }
    SEAM(6);
    if (IN(7)) {
        pg8::Gemm g{hb, (const bf16*)(ws + WS_W2GU), M, 2 * FF, D}; pg8::StaticOrder S; S.init(M, 2 * FF, G, c_x, WGM_UP); pg8::EpiSwiglu E{act, hpA, FF};
        pg8::gemm_phase<pg8::EpiSwiglu, pg8::StaticOrder, GP_ALIGN, GP_SP2>(lds, g, S, E);
    }
    SEAM_L(7);
    if (IN(8)) {
        pg8::Gemm g{act, (const bf16*)(ws + WS_W2D), M, D, FF}; pg8::StaticOrder S; S.init(M, D, G, c_x, WGM_DN);
        pg8::EpiRes<0, false, true, true> E{OUTP(), OUTP(), hb, hpB, nullptr, nullptr, 0.5f, 0.f};
        pg8::gemm_phase<pg8::EpiRes<0, false, true, true>, pg8::StaticOrder, GP_ALIGN, GP_SP2>(lds, g, S, E);
    }
    SEAM_L(8);
    if (IN(9)) {
        pg8::Gemm g{hb, (const bf16*)(ws + WS_WPG), M, D, D}; pg8::StaticOrder S; S.init(M, D, G, c_x);
        pg8::EpiRes<32, true, false, true> E{OUTP(), OUTP(), nullptr, hpA, hpB, ppb, 0.f, 1.0f / 2048.0f};
        pg8::gemm_phase<pg8::EpiRes<32, true, false, true>, pg8::StaticOrder, GP_ALIGN, GP_SP2>(lds, g, S, E);
    }
    SEAM_L(9);
    if (IN(10)) { final_phase(args, lane, wave, G, c_x, loc_ok); }
#undef IN
#undef SEAM
}

extern "C" void kernel_launch(void* const* d_in, const int* in_sizes, int n_in, void* d_out, int out_size, void* d_ws, size_t ws_size, hipStream_t stream) {
    if (n_in != 31 || out_size != M * D || ws_size < WS_END) { fprintf(stderr, "kernel_launch: unexpected shapes (n_in %d out %d ws %zu)\n", n_in, out_size, ws_size); return; }
    static int grid = 0;
    if (grid == 0) {
        int dev = 0, cus = 0, per_cu = 0;
        (void)hipGetDevice(&dev); (void)hipDeviceGetAttribute(&cus, hipDeviceAttributeMultiprocessorCount, dev);
        (void)hipFuncSetAttribute((const void*)fwd_kernel, hipFuncAttributeMaxDynamicSharedMemorySize, LDS_BYTES);
        (void)hipOccupancyMaxActiveBlocksPerMultiprocessor(&per_cu, (const void*)fwd_kernel, NWAVES * 64, LDS_BYTES);
        if (per_cu < 1) { fprintf(stderr, "kernel_launch: occupancy query says %d blocks/CU\n", per_cu); per_cu = 1; }
        (void)hipGetLastError();
        grid = cus * 1;
    }
    Args a{};
    for (int i = 0; i < 31; ++i) a.in[i] = (const float*)d_in[i];
    a.out = (float*)d_out; a.ws = (unsigned char*)d_ws;
#if ONE_LAUNCH
    a.ph_lo = 0; a.ph_hi = N_PHASES;
    void* kargs[] = {&a};
    hipError_t e = hipLaunchCooperativeKernel((const void*)fwd_kernel, dim3(grid), dim3(NWAVES * 64), kargs, LDS_BYTES, stream);
    if (e != hipSuccess) fprintf(stderr, "cooperative launch failed: %s (grid %d)\n", hipGetErrorString(e), grid);
#else
    for (int ph = 0; ph < 11; ++ph) { a.ph_lo = ph; a.ph_hi = ph + 1; hipLaunchKernelGGL(fwd_kernel, dim3(grid), dim3(NWAVES * 64), LDS_BYTES, stream, a); }
#endif
}
```

```cpp
#include <hip/hip_runtime.h>
#include <hip/hip_cooperative_groups.h>
#include <cstdio>
#include <cstdint>
namespace cg = cooperative_groups;
#define S5_FAST 1
#define ONE_LAUNCH 1
#define PG8_WGM 4
#ifndef PG8_WGM
#define PG8_WGM 8
#endif
namespace pg8 {
#define PG8_LAS __attribute__((address_space(3)))
typedef unsigned short bf16_t;
typedef short bf16x8 __attribute__((ext_vector_type(8)));
typedef float f32x4 __attribute__((ext_vector_type(4)));
typedef unsigned u32x4 __attribute__((ext_vector_type(4)));
constexpr int BM = 256, BK = 64, HALF = 128, HTB = HALF * BK * 2  , STAGE_BYTES = 8 * HTB, NXCD = 8, WGM = PG8_WGM;

__host__ __device__ __forceinline__ int lds_byte(int r, int c) { const int st = (r >> 4) * 2 + (c >> 5), rr = r & 15, cc = c & 31, ob = rr * 64 + cc * 2; return st * 1024 + (ob ^ (((ob >> 9) & 1) << 5)); }
__host__ __device__ __forceinline__ void stage_rc(int b, int& R, int& C) { const int st = b / 1024, sb = b % 1024, swz = sb ^ (((sb >> 9) & 1) << 5); R = (st >> 1) * 16 + swz / 64; C = (st & 1) * 32 + (swz % 64) / 2; }
__host__ __device__ __forceinline__ int perm32(int rho) { const int n = rho >> 4, i = rho & 15; return 8 * (i >> 2) + 4 * n + (i & 3); }

struct Unit { int pm, pn; };
struct Gemm { const bf16_t* A; const bf16_t* Bt; int M, N, K; };

struct StaticOrder {
    int nM, nN, nwg, G, c, wgm;
    __host__ __device__ void init(int M, int N, int G_, int c_, int wgm_ = PG8_WGM) { nM = M / BM; nN = N / BM; nwg = nM * nN; G = G_; c = c_; wgm = wgm_; }
    __host__ __device__ __forceinline__ bool next(int i, Unit& u) const {
        const long L = (long)i * G + c; if (L >= nwg) return false;
        int wgid = (int)L; { const int q = nwg / NXCD, r = nwg % NXCD, xcd = wgid % NXCD, off = wgid / NXCD; wgid = (xcd < r ? xcd * (q + 1) : r * (q + 1) + (xcd - r) * q) + off; }
        const int nig = wgm * nN, gid = wgid / nig, fm = gid * wgm, gsz = (nM - fm) < wgm ? (nM - fm) : wgm;
        u.pm = fm + ((wgid % nig) % gsz); u.pn = (wgid % nig) / gsz; return true;
    }
    __device__ __forceinline__ void a_ready(const Unit&) const {}
    __device__ __forceinline__ void done(const Unit&) const {}
};

__device__ __forceinline__ unsigned cvt_pk_bf16(float lo, float hi) { unsigned r; asm volatile("v_cvt_pk_bf16_f32 %0, %1, %2" : "=v"(r) : "v"(lo), "v"(hi)); return r; }
typedef float f32x2 __attribute__((ext_vector_type(2)));
constexpr float RMS_EPS = 1e-6f;
__device__ __forceinline__ float fast_sigmoid(float x) { return __builtin_amdgcn_rcpf(1.0f + __expf(-x)); }
__device__ __forceinline__ float gelu_tanh(float x) { const float u = x * (1.5957691216f + 0.0713548163f * x * x); return x * fast_sigmoid(u); }
__device__ __forceinline__ float bf_lo(unsigned w) { return __uint_as_float(w << 16); }
__device__ __forceinline__ float bf_hi(unsigned w) { return __uint_as_float(w & 0xffff0000u); }

template <int NP> __device__ __forceinline__ float row_total(const float* part, int row, int fq) {
    constexpr int PER = NP / 4;
    const float* p = part + (size_t)row * NP + fq * PER;
    float s;
    if constexpr (PER == 8) { const f32x4 a = *(const f32x4*)p, b = *(const f32x4*)(p + 4); s = ((a[0] + a[1]) + (a[2] + a[3])) + ((b[0] + b[1]) + (b[2] + b[3])); }
    else if constexpr (PER == 4) { const f32x4 a = *(const f32x4*)p; s = (a[0] + a[1]) + (a[2] + a[3]); }
    else { const f32x2 a = *(const f32x2*)p; s = a[0] + a[1]; }
    s += __shfl_xor(s, 16); s += __shfl_xor(s, 32);
    return s;
}

struct EpiSwiglu {
    static constexpr bool PERM = true, AFTER_DRAIN = false;
    bf16_t* O; const float* part; int ldo;
    __device__ __forceinline__ void operator()(const f32x4 (&acc)[2][2][4][2], const Unit& u, int wr, int wc, int fr, int fq) const {
        const int row0 = u.pm * BM + wr * 64 + fr, col0 = u.pn * 128 + wc * 32 + 8 * fq;
#ifndef EPI_SW_REPS
#define EPI_SW_REPS 1
#endif
#pragma unroll 1
        for (int rep_ = 0; rep_ < EPI_SW_REPS; ++rep_)
#pragma unroll
        for (int ai = 0; ai < 2; ++ai)
#pragma unroll
            for (int m = 0; m < 4; ++m) {
                const int row = row0 + ai * HALF + m * 16;
                const float r = rsqrtf(row_total<32>(part, row, fq) * (1.0f / 2048.0f) + RMS_EPS);
                f32x4 o0, o1;
#pragma unroll
                for (int j = 0; j < 4; ++j) { const float g = acc[ai][0][m][0][j] * r, up = acc[ai][1][m][0][j] * r; o0[j] = g * fast_sigmoid(g) * up; }
#pragma unroll
                for (int j = 0; j < 4; ++j) { const float g = acc[ai][0][m][1][j] * r, up = acc[ai][1][m][1][j] * r; o1[j] = g * fast_sigmoid(g) * up; }
                u32x4 w; w.x = cvt_pk_bf16(o0[0], o0[1]); w.y = cvt_pk_bf16(o0[2], o0[3]); w.z = cvt_pk_bf16(o1[0], o1[1]); w.w = cvt_pk_bf16(o1[2], o1[3]);
                *(u32x4*)(O + (size_t)row * ldo + col0) = w;
                asm volatile("" ::: "memory");
            }
    }
};

template <int NP> __device__ __forceinline__ void row_scales(const float* part, int row0, int fq, float inv_width, float (&sc)[8]) {
    constexpr int PER = NP / 4;
    float s[8];
    if constexpr (PER == 8) {
        f32x4 a[8], b[8];
#pragma unroll
        for (int i = 0; i < 8; ++i) { const float* p = part + (size_t)(row0 + (i >> 2) * HALF + (i & 3) * 16) * NP + fq * PER; a[i] = *(const f32x4*)p; b[i] = *(const f32x4*)(p + 4); }
#pragma unroll
        for (int i = 0; i < 8; ++i) s[i] = ((a[i][0] + a[i][1]) + (a[i][2] + a[i][3])) + ((b[i][0] + b[i][1]) + (b[i][2] + b[i][3]));
    } else if constexpr (PER == 4) {
        f32x4 a[8];
#pragma unroll
        for (int i = 0; i < 8; ++i) a[i] = *(const f32x4*)(part + (size_t)(row0 + (i >> 2) * HALF + (i & 3) * 16) * NP + fq * PER);
#pragma unroll
        for (int i = 0; i < 8; ++i) s[i] = (a[i][0] + a[i][1]) + (a[i][2] + a[i][3]);
    } else {
        f32x2 a[8];
#pragma unroll
        for (int i = 0; i < 8; ++i) a[i] = *(const f32x2*)(part + (size_t)(row0 + (i >> 2) * HALF + (i & 3) * 16) * NP + fq * PER);
#pragma unroll
        for (int i = 0; i < 8; ++i) s[i] = a[i][0] + a[i][1];
    }
#pragma unroll
    for (int i = 0; i < 8; ++i) { s[i] += __shfl_xor(s[i], 16); s[i] += __shfl_xor(s[i], 32); sc[i] = __builtin_amdgcn_rsqf(s[i] * inv_width + RMS_EPS); }
}

template <int SCALE_NP, bool GATE, bool WB, bool WP> struct EpiRes {
    static constexpr bool PERM = true, AFTER_DRAIN = false;
    const float* resid; float* out; bf16_t* hb; float* pout; const float* pin; const bf16_t* pp; float alpha; float inv_width;
    __device__ __forceinline__ void operator()(const f32x4 (&acc)[2][2][4][2], const Unit& u, int wr, int wc, int fr, int fq) const {
        const int row0 = u.pm * BM + wr * 64 + fr, col0 = u.pn * BM + wc * 32 + 8 * fq;
        float sc[8];
        if constexpr (SCALE_NP > 0) row_scales<SCALE_NP>(pin, row0, fq, inv_width, sc);
        f32x4 R[2][4]; u32x4 P[2][2];
#define EPIRES_LOAD(i, buf) { const size_t off_ = (size_t)(row0 + ((i) >> 2) * HALF + ((i) & 3) * 16) * 2048 + col0; \
            R[buf][0] = *(const f32x4*)(resid + off_); R[buf][1] = *(const f32x4*)(resid + off_ + 4); R[buf][2] = *(const f32x4*)(resid + off_ + HALF); R[buf][3] = *(const f32x4*)(resid + off_ + HALF + 4); \
            if constexpr (GATE) { P[buf][0] = *(const u32x4*)(pp + off_); P[buf][1] = *(const u32x4*)(pp + off_ + HALF); } }
        EPIRES_LOAD(0, 0)
#pragma unroll
        for (int i = 0; i < 8; ++i) {
            const int ai = i >> 2, m = i & 3, row = row0 + ai * HALF + m * 16, cb = i & 1;
            if (i < 7) EPIRES_LOAD(i + 1, cb ^ 1)
            const float scv = SCALE_NP > 0 ? sc[i] : alpha;
            float ss = 0.f;
#pragma unroll
            for (int bj = 0; bj < 2; ++bj) {
                const size_t off = (size_t)row * 2048 + col0 + bj * HALF;
                f32x4 a0 = acc[ai][bj][m][0] * scv, a1 = acc[ai][bj][m][1] * scv;
                if constexpr (GATE) {
                    const u32x4 pw = P[cb][bj];
                    a0[0] = fast_sigmoid(a0[0]) * bf_lo(pw.x); a0[1] = fast_sigmoid(a0[1]) * bf_hi(pw.x); a0[2] = fast_sigmoid(a0[2]) * bf_lo(pw.y); a0[3] = fast_sigmoid(a0[3]) * bf_hi(pw.y);
                    a1[0] = fast_sigmoid(a1[0]) * bf_lo(pw.z); a1[1] = fast_sigmoid(a1[1]) * bf_hi(pw.z); a1[2] = fast_sigmoid(a1[2]) * bf_lo(pw.w); a1[3] = fast_sigmoid(a1[3]) * bf_hi(pw.w);
                }
                const f32x4 o0 = R[cb][2 * bj] + a0, o1 = R[cb][2 * bj + 1] + a1;
#ifdef RES_NT
                __builtin_nontemporal_store(o0, (f32x4*)(out + off)); __builtin_nontemporal_store(o1, (f32x4*)(out + off + 4));
#else
                *(f32x4*)(out + off) = o0; *(f32x4*)(out + off + 4) = o1;
#endif
                if constexpr (WP) ss += ((o0[0] * o0[0] + o0[1] * o0[1]) + (o0[2] * o0[2] + o0[3] * o0[3])) + ((o1[0] * o1[0] + o1[1] * o1[1]) + (o1[2] * o1[2] + o1[3] * o1[3]));
                if constexpr (WB) { u32x4 w; w.x = cvt_pk_bf16(o0[0], o0[1]); w.y = cvt_pk_bf16(o0[2], o0[3]); w.z = cvt_pk_bf16(o1[0], o1[1]); w.w = cvt_pk_bf16(o1[2], o1[3]); *(u32x4*)(hb + off) = w; }
            }
            if constexpr (WP) { ss += __shfl_xor(ss, 16); ss += __shfl_xor(ss, 32); if (fq == 0) pout[(size_t)row * 32 + u.pn * 4 + wc] = ss; }
            asm volatile("" ::: "memory");
        }
#undef EPIRES_LOAD
    }
};

struct EpiWin {
    static constexpr bool PERM = true, AFTER_DRAIN = false;
    bf16_t* zs; size_t off_u, off_v; float* lnp; const float* part;
    __device__ __forceinline__ void operator()(const f32x4 (&acc)[2][2][4][2], const Unit& u, int wr, int wc, int fr, int fq) const {
        const int kind = u.pn >> 2, ct = u.pn & 3;
        const int row0 = u.pm * BM + wr * 64 + fr, col0 = ct * BM + wc * 32 + 8 * fq;
        bf16_t* dst = zs + (size_t)(kind == 1) * off_u + (size_t)(kind == 2) * off_v; const int ldd = 1024 << (kind == 1);
#pragma unroll
        for (int ai = 0; ai < 2; ++ai)
#pragma unroll
            for (int m = 0; m < 4; ++m) {
                const int row = row0 + ai * HALF + m * 16;
                const float r = rsqrtf(row_total<32>(part, row, fq) * (1.0f / 2048.0f) + RMS_EPS);
                float s1 = 0.f, s2 = 0.f;
#pragma unroll
                for (int bj = 0; bj < 2; ++bj) {
                    f32x4 o0 = acc[ai][bj][m][0] * r, o1 = acc[ai][bj][m][1] * r;
                    if (kind != 0) {
#pragma unroll
                        for (int j = 0; j < 4; ++j) { o0[j] = gelu_tanh(o0[j]); o1[j] = gelu_tanh(o1[j]); } }
                    s1 += ((o0[0] + o0[1]) + (o0[2] + o0[3])) + ((o1[0] + o1[1]) + (o1[2] + o1[3]));
                    s2 += ((o0[0] * o0[0] + o0[1] * o0[1]) + (o0[2] * o0[2] + o0[3] * o0[3])) + ((o1[0] * o1[0] + o1[1] * o1[1]) + (o1[2] * o1[2] + o1[3] * o1[3]));
                    u32x4 w; w.x = cvt_pk_bf16(o0[0], o0[1]); w.y = cvt_pk_bf16(o0[2], o0[3]); w.z = cvt_pk_bf16(o1[0], o1[1]); w.w = cvt_pk_bf16(o1[2], o1[3]);
                    *(u32x4*)(dst + (size_t)row * ldd + col0 + bj * HALF) = w;
                }
                if (kind == 2) {
                    s1 += __shfl_xor(s1, 16); s1 += __shfl_xor(s1, 32); s2 += __shfl_xor(s2, 16); s2 += __shfl_xor(s2, 32);
                    if (fq == 0) *(f32x2*)(lnp + ((size_t)row * 16 + ct * 4 + wc) * 2) = (f32x2){s1, s2};
                }
                asm volatile("" ::: "memory");
            }
    }
};

struct EpiGlu {
    static constexpr bool PERM = true, AFTER_DRAIN = false;
    const bf16_t* yg; bf16_t* ys; float* ssp;
    __device__ __forceinline__ void operator()(const f32x4 (&acc)[2][2][4][2], const Unit& u, int wr, int wc, int fr, int fq) const {
        const int row0 = u.pm * BM + wr * 64 + fr, col0 = u.pn * BM + wc * 32 + 8 * fq;
#pragma unroll
        for (int ai = 0; ai < 2; ++ai)
#pragma unroll
            for (int m = 0; m < 4; ++m) {
                const int row = row0 + ai * HALF + m * 16;
                float ss = 0.f;
#pragma unroll
                for (int bj = 0; bj < 2; ++bj) {
                    const size_t off = (size_t)row * 1024 + col0 + bj * HALF, offo = (size_t)row * 2048 + col0 + bj * HALF;
                    const u32x4 yw = *(const u32x4*)(yg + off);
                    float o[8];
                    o[0] = bf_lo(yw.x) * fast_sigmoid(acc[ai][bj][m][0][0]); o[1] = bf_hi(yw.x) * fast_sigmoid(acc[ai][bj][m][0][1]);
                    o[2] = bf_lo(yw.y) * fast_sigmoid(acc[ai][bj][m][0][2]); o[3] = bf_hi(yw.y) * fast_sigmoid(acc[ai][bj][m][0][3]);
                    o[4] = bf_lo(yw.z) * fast_sigmoid(acc[ai][bj][m][1][0]); o[5] = bf_hi(yw.z) * fast_sigmoid(acc[ai][bj][m][1][1]);
                    o[6] = bf_lo(yw.w) * fast_sigmoid(acc[ai][bj][m][1][2]); o[7] = bf_hi(yw.w) * fast_sigmoid(acc[ai][bj][m][1][3]);
#pragma unroll
                    for (int e = 0; e < 8; ++e) ss += o[e] * o[e];
                    u32x4 w; w.x = cvt_pk_bf16(o[0], o[1]); w.y = cvt_pk_bf16(o[2], o[3]); w.z = cvt_pk_bf16(o[4], o[5]); w.w = cvt_pk_bf16(o[6], o[7]);
                    *(u32x4*)(ys + offo) = w;
                }
                ss += __shfl_xor(ss, 16); ss += __shfl_xor(ss, 32);
                if (fq == 0) ssp[(size_t)row * 16 + u.pn * 4 + wc] = ss;
            }
    }
};

struct EpiPlain {
    static constexpr bool PERM = true, AFTER_DRAIN = false;
    bf16_t* O; int ldo;
    __device__ __forceinline__ void operator()(const f32x4 (&acc)[2][2][4][2], const Unit& u, int wr, int wc, int fr, int fq) const {
        const int row0 = u.pm * BM + wr * 64 + fr, col0 = u.pn * BM + wc * 32 + 8 * fq;
#pragma unroll
        for (int ai = 0; ai < 2; ++ai)
#pragma unroll
            for (int m = 0; m < 4; ++m)
#pragma unroll
                for (int bj = 0; bj < 2; ++bj) {
                    const f32x4 v0 = acc[ai][bj][m][0], v1 = acc[ai][bj][m][1];
                    u32x4 w; w.x = cvt_pk_bf16(v0[0], v0[1]); w.y = cvt_pk_bf16(v0[2], v0[3]); w.z = cvt_pk_bf16(v1[0], v1[1]); w.w = cvt_pk_bf16(v1[2], v1[3]);
                    *(u32x4*)(O + (size_t)(row0 + ai * HALF + m * 16) * ldo + col0 + bj * HALF) = w;
                }
    }
};
template <class Epi, class Sched, bool ALIGN_EPI = false, bool SP2 = false, bool MID = false>
__device__ __forceinline__ void gemm_phase(PG8_LAS unsigned char* lds, const Gemm g, const Sched& S, const Epi& E, const PG8_LAS float* midtab = nullptr) {
    int tid = threadIdx.x; asm volatile("" : "+v"(tid));
    const int wid = __builtin_amdgcn_readfirstlane(tid >> 6), lane = tid & 63, wr = wid >> 2, wc = wid & 3, fr = lane & 15, fq = lane >> 4;
    int K = g.K; asm volatile("" : "+s"(K));     const int nt = K / BK;
    unsigned voffA[2], voffB[2];
#pragma unroll
    for (int i = 0; i < 2; ++i) { int R, C; stage_rc(tid * 16 + i * 8192, R, C); const int Rb = Epi::PERM ? ((R & ~31) + perm32(R & 31)) : R;
        voffA[i] = (unsigned)(R * K + C) * 2u; voffB[i] = (unsigned)(Rb * K + C) * 2u; }
    const size_t kstep = (size_t)(BK * 2);
    const size_t hstep = (size_t)HALF * K * 2;
    const size_t tstep = 2 * hstep;
    const unsigned ldsw = (unsigned)wid * 1024u;
    const int aoff = lds_byte(wr * 64 + fr, fq * 8), boff = lds_byte(wc * 32 + fr, fq * 8);
#define PG8_SA(b, h) (((b) * 2 + (h)) * HTB)
#define PG8_SB(b, h) ((4 + (b) * 2 + (h)) * HTB)
#ifndef PG8_A_AUX
#define PG8_A_AUX 0
#endif
#ifndef PG8_B_AUX
#define PG8_B_AUX 0
#endif
#define PG8_AUX_voffA PG8_A_AUX
#define PG8_AUX_voffB PG8_B_AUX
#define PG8_STAGE(bufoff, gbase, voff) do { _Pragma("unroll") for (int _i = 0; _i < 2; ++_i) \
        __builtin_amdgcn_global_load_lds((const unsigned*)((const char*)(gbase) + (voff)[_i]), (PG8_LAS unsigned*)(lds + (bufoff) + ldsw + _i * 8192), 16, 0, PG8_AUX_##voff); } while (0)
#define PG8_LDA(dst, b, h) do { _Pragma("unroll") for (int m = 0; m < 4; ++m) _Pragma("unroll") for (int k = 0; k < 2; ++k) dst[m][k] = *(const PG8_LAS bf16x8*)(lds + PG8_SA(b, h) + aoff + m * 2048 + k * 1024); } while (0)
#define PG8_LDB(dst, b, h) do { _Pragma("unroll") for (int n = 0; n < 2; ++n) _Pragma("unroll") for (int k = 0; k < 2; ++k) dst[n][k] = *(const PG8_LAS bf16x8*)(lds + PG8_SB(b, h) + boff + n * 2048 + k * 1024); } while (0)
#define PG8_MMA(ai, bj, At, Bt) do { __builtin_amdgcn_s_setprio(1); _Pragma("unroll") for (int m = 0; m < 4; ++m) _Pragma("unroll") for (int n = 0; n < 2; ++n) _Pragma("unroll") for (int k = 0; k < 2; ++k) \
        acc[ai][bj][m][n] = __builtin_amdgcn_mfma_f32_16x16x32_bf16(Bt[n][k], At[m][k], acc[ai][bj][m][n], 0, 0, 0); __builtin_amdgcn_s_setprio(0); } while (0)
#define PG8_WAIT_V(n) asm volatile("s_waitcnt vmcnt(" #n ")" ::: "memory")
#define PG8_WAIT_L(n) asm volatile("s_waitcnt lgkmcnt(" #n ")" ::: "memory")
#define PG8_BAR __builtin_amdgcn_s_barrier()
#define PG8_SCHED __builtin_amdgcn_sched_barrier(0)
    Unit cur, nxt; int ui = 0;
    if (!S.next(0, cur)) return;
    f32x4 acc[2][2][4][2];
#pragma unroll
    for (int a = 0; a < 2; ++a)
#pragma unroll
        for (int b = 0; b < 2; ++b)
#pragma unroll
            for (int m = 0; m < 4; ++m)
#pragma unroll
                for (int n = 0; n < 2; ++n) acc[a][b][m][n] = (f32x4){0.f, 0.f, 0.f, 0.f};
    bf16x8 At[4][2], B0[2][2], B1[2][2];
    const char* cA = (const char*)g.A + (size_t)cur.pm * tstep; const char* cB = (const char*)g.Bt + (size_t)cur.pn * tstep;
    S.a_ready(cur);
    if constexpr (SP2) {
        PG8_STAGE(PG8_SB(0, 0), cB, voffB); PG8_STAGE(PG8_SB(0, 1), cB + hstep, voffB); PG8_STAGE(PG8_SA(0, 0), cA, voffA); PG8_STAGE(PG8_SA(0, 1), cA + hstep, voffA);
        if (wr == 1) PG8_BAR;
        PG8_WAIT_V(2); PG8_BAR;
        PG8_STAGE(PG8_SB(1, 0), cB + kstep, voffB); PG8_STAGE(PG8_SA(1, 0), cA + kstep, voffA); PG8_STAGE(PG8_SB(1, 1), cB + hstep + kstep, voffB);
        PG8_WAIT_V(6); PG8_BAR;
    } else {
        PG8_STAGE(PG8_SB(0, 0), cB, voffB); PG8_STAGE(PG8_SA(0, 0), cA, voffA); PG8_STAGE(PG8_SB(0, 1), cB + hstep, voffB); PG8_STAGE(PG8_SA(0, 1), cA + hstep, voffA);
        if (wr == 1) PG8_BAR;
        PG8_WAIT_V(4); PG8_BAR;
        PG8_STAGE(PG8_SB(1, 0), cB + kstep, voffB); PG8_STAGE(PG8_SA(1, 0), cA + kstep, voffA); PG8_STAGE(PG8_SB(1, 1), cB + hstep + kstep, voffB);
        PG8_WAIT_V(6); PG8_BAR;
    }
    for (;;) {
        const bool has_next = S.next(ui + 1, nxt);
        const char* nA = has_next ? (const char*)g.A + (size_t)nxt.pm * tstep : cA; const char* nB = has_next ? (const char*)g.Bt + (size_t)nxt.pn * tstep : cB;
        for (int t = 0; t < nt; t += 2) {
            const bool last = (t == nt - 2);
            const char* a1 = cA + (size_t)(t + 1) * kstep;
            const char* a2 = last ? nA : cA + (size_t)(t + 2) * kstep; const char* b2 = last ? nB : cB + (size_t)(t + 2) * kstep;
            const char* a3 = a2 + kstep; const char* b3 = b2 + kstep;
            if (last && has_next) S.a_ready(nxt);
            if constexpr (MID) { if (t == (nt >> 1)) {
#pragma unroll
                for (int ai = 0; ai < 2; ++ai)
#pragma unroll
                    for (int m = 0; m < 4; ++m) { const float f = midtab[(ui & 7) * 256 + ai * HALF + wr * 64 + m * 16 + fr];
#pragma unroll
                        for (int bj = 0; bj < 2; ++bj)
#pragma unroll
                            for (int n = 0; n < 2; ++n) acc[ai][bj][m][n] *= f; } } }
            if constexpr (SP2) {
            PG8_LDB(B0, 0, 0); PG8_LDB(B1, 0, 1); PG8_SCHED; PG8_LDA(At, 0, 0); PG8_STAGE(PG8_SA(1, 1), a1 + hstep, voffA);
            PG8_WAIT_V(8); PG8_WAIT_L(0); PG8_BAR; PG8_MMA(0, 0, At, B0); PG8_MMA(0, 1, At, B1); PG8_BAR; PG8_SCHED;
            PG8_LDA(At, 0, 1); PG8_STAGE(PG8_SB(0, 0), b2, voffB); PG8_STAGE(PG8_SB(0, 1), b2 + hstep, voffB); PG8_STAGE(PG8_SA(0, 0), a2, voffA);
            PG8_WAIT_V(8); PG8_WAIT_L(0); PG8_BAR; PG8_MMA(1, 0, At, B0); PG8_MMA(1, 1, At, B1); PG8_BAR; PG8_SCHED;
            PG8_LDB(B0, 1, 0); PG8_LDB(B1, 1, 1); PG8_SCHED; PG8_LDA(At, 1, 0); PG8_STAGE(PG8_SA(0, 1), a2 + hstep, voffA);
            PG8_WAIT_V(8); PG8_WAIT_L(0); PG8_BAR; PG8_MMA(0, 0, At, B0); PG8_MMA(0, 1, At, B1); PG8_BAR; PG8_SCHED;
            PG8_LDA(At, 1, 1); PG8_STAGE(PG8_SB(1, 0), b3, voffB); PG8_STAGE(PG8_SB(1, 1), b3 + hstep, voffB); PG8_STAGE(PG8_SA(1, 0), a3, voffA);
            PG8_WAIT_V(8); PG8_WAIT_L(0); PG8_BAR; PG8_MMA(1, 0, At, B0); PG8_MMA(1, 1, At, B1); PG8_BAR; PG8_SCHED;
            } else {
            PG8_LDB(B0, 0, 0); PG8_SCHED; PG8_LDA(At, 0, 0); PG8_STAGE(PG8_SA(1, 1), a1 + hstep, voffA);
            PG8_WAIT_L(8); PG8_BAR; PG8_WAIT_L(0); PG8_MMA(0, 0, At, B0); PG8_BAR; PG8_SCHED;
            PG8_LDB(B1, 0, 1); PG8_STAGE(PG8_SB(0, 0), b2, voffB);
            PG8_BAR; PG8_WAIT_L(0); PG8_MMA(0, 1, At, B1); PG8_BAR;
            PG8_LDA(At, 0, 1); PG8_STAGE(PG8_SA(0, 0), a2, voffA);
            PG8_BAR; PG8_WAIT_L(0); PG8_MMA(1, 0, At, B0); PG8_BAR; PG8_SCHED;
            PG8_STAGE(PG8_SB(0, 1), b2 + hstep, voffB);
            PG8_WAIT_V(6); PG8_BAR; PG8_MMA(1, 1, At, B1); PG8_BAR;
            PG8_LDB(B0, 1, 0); PG8_SCHED; PG8_LDA(At, 1, 0); PG8_STAGE(PG8_SA(0, 1), a2 + hstep, voffA);
            PG8_WAIT_L(8); PG8_BAR; PG8_WAIT_L(0); PG8_MMA(0, 0, At, B0); PG8_BAR; PG8_SCHED;
            PG8_LDB(B1, 1, 1); PG8_STAGE(PG8_SB(1, 0), b3, voffB);
            PG8_BAR; PG8_WAIT_L(0); PG8_MMA(0, 1, At, B1); PG8_BAR;
            PG8_LDA(At, 1, 1); PG8_STAGE(PG8_SA(1, 0), a3, voffA);
            PG8_BAR; PG8_WAIT_L(0); PG8_MMA(1, 0, At, B0); PG8_BAR; PG8_SCHED;
            PG8_STAGE(PG8_SB(1, 1), b3 + hstep, voffB);
            PG8_WAIT_V(6); PG8_BAR; PG8_MMA(1, 1, At, B1); PG8_BAR;
            }
        }
        if constexpr (ALIGN_EPI) { if (wr == 0) PG8_BAR; }
        if constexpr (!Epi::AFTER_DRAIN) { E(acc, cur, wr, wc, fr, fq); S.done(cur); }
        if (!has_next) break;
#pragma unroll
        for (int a = 0; a < 2; ++a)
#pragma unroll
            for (int b = 0; b < 2; ++b)
#pragma unroll
                for (int m = 0; m < 4; ++m)
#pragma unroll
                    for (int n = 0; n < 2; ++n) acc[a][b][m][n] = (f32x4){0.f, 0.f, 0.f, 0.f};
        cur = nxt; cA = nA; cB = nB; ++ui;
        if constexpr (ALIGN_EPI) { if (wr == 1) PG8_BAR; }
    }
    PG8_WAIT_V(0);
    if constexpr (!ALIGN_EPI) { if (wr == 0) PG8_BAR; }
    PG8_BAR;
    if constexpr (Epi::AFTER_DRAIN) { E.fused(acc, cur, wr, wc, fr, fq, lds, wid, lane); S.done(cur); }
#undef PG8_SA
#undef PG8_SB
#undef PG8_STAGE
#undef PG8_LDA
#undef PG8_LDB
#undef PG8_MMA
#undef PG8_WAIT_V
#undef PG8_WAIT_L
#undef PG8_BAR
#undef PG8_SCHED
}
}
#define LAS __attribute__((address_space(3)))
#define GAS __attribute__((address_space(1)))
typedef unsigned short bf16;
typedef unsigned v4u __attribute__((ext_vector_type(4)));
typedef unsigned v2u __attribute__((ext_vector_type(2)));
typedef float f32x4 __attribute__((ext_vector_type(4)));
typedef float f32x2 __attribute__((ext_vector_type(2)));
typedef short bf16x8 __attribute__((ext_vector_type(8)));
#define LDS_WAIT() asm volatile("s_waitcnt lgkmcnt(0)" ::: "memory")

#define XB_TMO      128
#define XB_XCNT(j)  (256  + 64 * (j))
#define XB_XSUB(j)  (1280 + 64 * (j))
#define XB_XGEN(j)  (2304 + 64 * (j))
#define XB_TOP      3328
#define XB_TOPGEN   3392
#define XCD_BAR_WORDS 3456
#define XB_SPIN_CAP (1u << 18)

__device__ __forceinline__ unsigned xb_ld(unsigned* p)              { return __hip_atomic_load(p, __ATOMIC_RELAXED, __HIP_MEMORY_SCOPE_AGENT); }
__device__ __forceinline__ unsigned xb_add(unsigned* p, unsigned v) { return __hip_atomic_fetch_add(p, v, __ATOMIC_RELAXED, __HIP_MEMORY_SCOPE_AGENT); }
__device__ __forceinline__ unsigned xb_xcc_id() { return (unsigned)__builtin_amdgcn_s_getreg((3 << 11) | 20) & 0xFu; }
#define XB_SPIN(cond, bar) do { unsigned _sp = 0; while (cond) { __builtin_amdgcn_s_sleep(1); \
    if ((++_sp & 255u) == 0u) { if (xb_ld(&(bar)[XB_TMO])) break; if (_sp > XB_SPIN_CAP) { atomicAdd(&(bar)[XB_TMO], 1u); break; } } } } while (0)

struct XcdBarrier {
    unsigned* bar; unsigned x;
    volatile LAS unsigned* st;
};

__device__ __forceinline__ XcdBarrier xcd_barrier_post(unsigned* bar, volatile LAS unsigned* st) {
    XcdBarrier b; b.bar = bar; b.x = xb_xcc_id(); b.st = st;
    if (threadIdx.x == 0) st[2] = xb_add(&bar[XB_XCNT(b.x)], 1u);
    return b;
}
__device__ __forceinline__ void xcd_barrier_complete(unsigned* bar, unsigned x, unsigned& nloc, unsigned& nx) {
    const unsigned G = gridDim.x * gridDim.y * gridDim.z;
    unsigned sum, cnt, mine, sp = 0u;
    for (;;) {
        sum = 0u; cnt = 0u; mine = 0u;
#pragma unroll
        for (unsigned j = 0; j < 16; ++j) { const unsigned c = xb_ld(&bar[XB_XCNT(j)]); sum += c; cnt += (c > 0u) ? 1u : 0u; mine = (j == x) ? c : mine; }
        if (sum == G) break;
        __builtin_amdgcn_s_sleep(1);
        if ((++sp & 255u) == 0u) { if (xb_ld(&bar[XB_TMO])) break; if (sp > XB_SPIN_CAP) { atomicAdd(&bar[XB_TMO], 1u); break; } }
    }
    nloc = mine > 0u ? mine : 1u; nx = cnt > 0u ? cnt : 1u;
}

__device__ __forceinline__ void xcd_barrier(const XcdBarrier& b) {
    asm volatile("s_waitcnt vmcnt(0)" ::: "memory");
    __syncthreads();
    if (threadIdx.x == 0) {
        unsigned* bar = b.bar;
        __builtin_amdgcn_s_waitcnt(0);
        unsigned nloc = b.st[0], nx = b.st[1];
        if (nloc == 0u) { xcd_barrier_complete(bar, b.x, nloc, nx); b.st[0] = nloc; b.st[1] = nx; }
        const unsigned old = xb_add(&bar[XB_XSUB(b.x)], 1u);
        const unsigned gen = old / nloc;
        if (old + 1u == (gen + 1u) * nloc) {
            __builtin_amdgcn_fence(__ATOMIC_RELEASE, "agent");
            asm volatile("s_waitcnt vmcnt(0)" ::: "memory");
            const unsigned og = xb_add(&bar[XB_TOP], 1u);
            const unsigned tg = og / nx;
            if (og + 1u == (tg + 1u) * nx) xb_add(&bar[XB_TOPGEN], 1u);
            else XB_SPIN(xb_ld(&bar[XB_TOPGEN]) == tg, bar);
            __builtin_amdgcn_fence(__ATOMIC_ACQUIRE, "agent");
            xb_add(&bar[XB_XGEN(b.x)], 1u);
            asm volatile("s_waitcnt vmcnt(0)" ::: "memory");
        } else {
            XB_SPIN(xb_ld(&bar[XB_XGEN(b.x)]) == gen, bar);
            __builtin_amdgcn_fence(__ATOMIC_ACQUIRE, "agent");
            asm volatile("s_waitcnt vmcnt(0)" ::: "memory");
        }
    }
    __syncthreads();
}

__device__ __forceinline__ void xcd_local_barrier(const XcdBarrier& b) {
    asm volatile("s_waitcnt vmcnt(0)" ::: "memory");
    __syncthreads();
    if (threadIdx.x == 0) {
        unsigned* bar = b.bar;
        __builtin_amdgcn_s_waitcnt(0);
        const unsigned nloc = b.st[0];
        const unsigned old = xb_add(&bar[XB_XSUB(b.x)], 1u);
        const unsigned gen = old / nloc;
        if (old + 1u == (gen + 1u) * nloc) xb_add(&bar[XB_XGEN(b.x)], 1u);
        else XB_SPIN(xb_ld(&bar[XB_XGEN(b.x)]) == gen, bar);
        __builtin_amdgcn_fence(__ATOMIC_ACQUIRE, "agent");
        asm volatile("s_waitcnt vmcnt(0)" ::: "memory");
    }
    __syncthreads();
}


#ifndef WGM_UP
#define WGM_UP PG8_WGM
#endif
#ifndef WGM_DN
#define WGM_DN PG8_WGM
#endif
#ifndef GP_ALIGN_RES
#define GP_ALIGN_RES true
#endif
#ifndef GP_ALIGN
#define GP_ALIGN true
#endif
#ifndef GP_SP2
#define GP_SP2 true
#endif
#ifndef S5_FAST
#define S5_FAST 1
#endif
#ifndef ONE_LAUNCH
#define ONE_LAUNCH 1
#endif

constexpr int NWAVES = 8;
constexpr int M = 16384, D = 2048, FF = 5632, DSSM = 1024, DG = 1024, DIN = 3072, DPLE = 256, SEQ = 4096;
constexpr float EPS = 1e-6f;
constexpr size_t MiB = 1u << 20;
constexpr size_t WS_W1GU = 1 * MiB, WS_W1D = 45 * MiB, WS_WIN = 67 * MiB, WS_WGLU = 79 * MiB, WS_WO = 81 * MiB, WS_W2GU = 89 * MiB, WS_W2D = 133 * MiB,
                 WS_WPG = 155 * MiB, WS_WPP = 163 * MiB, WS_S5W1 = 164 * MiB, WS_S5W3 = 168 * MiB, WS_S5C = 180 * MiB, WS_HPA = 181 * MiB, WS_HPB = 183 * MiB, WS_LNP = 185 * MiB,
                 WS_SSP = 187 * MiB, WS_GSP = 188 * MiB, WS_PB = 189 * MiB, WS_HB = 197 * MiB, WS_ACT = 261 * MiB, WS_ZS = 261 * MiB, WS_GV = 293 * MiB,
                 WS_YG = 325 * MiB, WS_YCAT = 357 * MiB  , WS_PP = 437 * MiB, WS_END = 501 * MiB;
constexpr int RING_BYTES = 131072, LDS_BYTES = 163840, MISC_OFF = LDS_BYTES - 256;
constexpr int S5_IMG_BYTES = 144 * 1024;

__device__ __forceinline__ unsigned f2bf(float f) { unsigned u = __builtin_bit_cast(unsigned, f); return (u + 0x7fffu + ((u >> 16) & 1u)) >> 16; }
__device__ __forceinline__ unsigned pk2(float lo, float hi) { return f2bf(lo) | (f2bf(hi) << 16); }
__device__ __forceinline__ float bflo(unsigned w) { return __uint_as_float(w << 16); }
__device__ __forceinline__ float bfhi(unsigned w) { return __uint_as_float(w & 0xffff0000u); }
__device__ __forceinline__ float wave_sum(float v) {
#pragma unroll
    for (int o = 1; o < 64; o <<= 1) v += __shfl_xor(v, o);
    return v;
}

struct Args { const float* in[31]; float* out; unsigned char* ws; int ph_lo, ph_hi; };
#define KARG_PTR(T, i) (((T const volatile __attribute__((address_space(4)))*)__builtin_amdgcn_kernarg_segment_ptr())[i])
#define INP(i) KARG_PTR(const float*, i)
#define OUTP() KARG_PTR(float*, 31)
#define WSP() KARG_PTR(unsigned char*, 32)
#define KARG_INT(i) KARG_PTR(int, i)
static_assert(sizeof(Args) == 33 * 8 + 8, "Args has no padding");

__device__ __forceinline__ void p0_transpose_item(const float* W, int K, int N, bf16* WT, const float* gain, int map, LAS float* scr, int item, int lane, int ldk = 0) {
    if (ldk == 0) ldk = K;
    const int nblk = N / 32, kb = item / nblk, nb = item % nblk, k0 = 64 * kb, n0 = 32 * nb;
#pragma unroll 8
    for (int i = 0; i < 32; ++i) { const int kk = 2 * i + (lane >> 5); scr[kk * 33 + (lane & 31)] = W[(size_t)(k0 + kk) * N + n0 + (lane & 31)]; }
    LDS_WAIT(); asm volatile("" ::: "memory");
    const int c = lane & 7;
    float gk[8];
#pragma unroll
    for (int e = 0; e < 8; ++e) gk[e] = gain ? gain[k0 + 8 * c + e] : 1.0f;
#pragma unroll
    for (int j = 0; j < 4; ++j) { const int nl = (lane >> 3) + 8 * j; const int n = n0 + nl; const LAS float* s = scr + (8 * c) * 33 + nl;
        const int drow = map == 0 ? n : (256 * (n >> 7) + (n & 127) + (map == 2 ? 128 : 0));
        v4u o; o.x = pk2(s[0 * 33] * gk[0], s[1 * 33] * gk[1]); o.y = pk2(s[2 * 33] * gk[2], s[3 * 33] * gk[3]); o.z = pk2(s[4 * 33] * gk[4], s[5 * 33] * gk[5]); o.w = pk2(s[6 * 33] * gk[6], s[7 * 33] * gk[7]);
        *(v4u*)(WT + (size_t)drow * ldk + k0 + 8 * c) = o; }
    LDS_WAIT(); asm volatile("" ::: "memory");
}

__device__ __forceinline__ void s5_gen(const Args& a, int g, LAS float* L, int tid) {
    LAS float* Pr = L; LAS float* Pi = L + 21 * 64; LAS float* Bbr = L + 42 * 64; LAS float* Bbi = Bbr + 1024; LAS float* Kd = Bbi + 1024;
    const float* log_dt = INP(8); const float* a_re = INP(9); const float* a_im = INP(10); const float* b_re = INP(11); const float* b_im = INP(12);
    const float* c_re = INP(13); const float* c_im = INP(14); const float* dvec = INP(15);
    bf16* W1 = (bf16*)(WSP() + WS_S5W1 + (size_t)g * S5_IMG_BYTES); bf16* W3C = W1 + 64 * 512; bf16* W3T = W1 + 128 * 512; float* SC = (float*)(WSP() + WS_S5C) + (size_t)g * 640;
    LAS float* Cr = Kd + 4096; LAS float* Ci = Cr + 1024; LAS float* Zr = Ci + 1024; LAS float* Zi = Zr + 64;
    const double dt = exp((double)log_dt[g]);
    for (int idx = tid; idx < 21 * 64; idx += 512) {
        const int n = idx & 63, k = idx >> 6;
        const double lr = fmin((double)a_re[g * 64 + n], -1e-4), li = (double)a_im[g * 64 + n];
        const double kk = k <= 16 ? (double)k : (k == 17 ? 32.0 : (k == 18 ? 64.0 : (k == 19 ? 128.0 : 512.0)));
        const double mag = exp(lr * dt * kk), ang = li * dt * kk;
        Pr[k * 64 + n] = (float)(mag * cos(ang)); Pi[k * 64 + n] = (float)(mag * sin(ang));
    }
    if (tid < 64) {
        const int n = tid;
        const double lr = fmin((double)a_re[g * 64 + n], -1e-4), li = (double)a_im[g * 64 + n];
        const double mag = exp(lr * dt), ang = li * dt, abr = mag * cos(ang), abi = mag * sin(ang);
        const double xr = abr - 1.0, xi = abi, den = lr * lr + li * li;
        Zr[n] = (float)((xr * lr + xi * li) / den); Zi[n] = (float)((xi * lr - xr * li) / den);
    }
    for (int idx = tid; idx < 1024; idx += 512) { Cr[idx] = c_re[g * 1024 + idx]; Ci[idx] = c_im[g * 1024 + idx]; }
    __syncthreads();
    for (int idx = tid; idx < 1024; idx += 512) { const int n = idx >> 4; const float br = b_re[g * 1024 + idx], bi = b_im[g * 1024 + idx], zr = Zr[n], zi = Zi[n];
        Bbr[idx] = zr * br - zi * bi; Bbi[idx] = zr * bi + zi * br; }
    for (int idx = tid; idx < 640; idx += 512) { const int l = idx >> 7, ri = (idx >> 6) & 1, n = idx & 63, k = l == 0 ? 16 : 16 + l; SC[idx] = ri ? Pi[k * 64 + n] : Pr[k * 64 + n]; }
    __syncthreads();
    for (int idx = tid; idx < 4096; idx += 512) {
        const int d = idx >> 8, p = (idx >> 4) & 15, pq = idx & 15; float s = 0.f;
        for (int n = 0; n < 64; ++n) { const float pr = Pr[d * 64 + n], pi = Pi[d * 64 + n], br = Bbr[n * 16 + pq], bi = Bbi[n * 16 + pq];
            const float xr = pr * br - pi * bi, xi = pr * bi + pi * br; s += Cr[p * 64 + n] * xr - Ci[p * 64 + n] * xi; }
        Kd[idx] = s;
    }
    __syncthreads();
    for (int id = tid; id < 64 * 64; id += 512) {
        const int f = id >> 6, lane = id & 63, mt = f >> 3, ks = f & 7, q = lane >> 4, r = lane & 15, np = 16 * mt + r, n = np & 63, s = 2 * ks + (q >> 1);
        const float pr = Pr[(15 - s) * 64 + n], pi = Pi[(15 - s) * 64 + n]; float v[8];
#pragma unroll
        for (int e = 0; e < 8; ++e) { const int p = 8 * (q & 1) + e; const float br = Bbr[n * 16 + p], bi = Bbi[n * 16 + p]; v[e] = np < 64 ? (pr * br - pi * bi) : (pr * bi + pi * br); }
        v4u o; o.x = pk2(v[0], v[1]); o.y = pk2(v[2], v[3]); o.z = pk2(v[4], v[5]); o.w = pk2(v[6], v[7]);
        *(v4u*)(W1 + (size_t)id * 8) = o;
    }
    for (int id = tid; id < 64 * 64; id += 512) {
        const int f = id >> 6, lane = id & 63, t = f >> 2, ks = f & 3, q = lane >> 4, p = lane & 15; float v[8];
#pragma unroll
        for (int e = 0; e < 8; ++e) { const int mtp = 2 * ks + (e >> 2), j = e & 3, n = 16 * (mtp & 3) + 4 * q + j;
            const float cr = Cr[p * 64 + n], ci = Ci[p * 64 + n], pr = Pr[(t + 1) * 64 + n], pi = Pi[(t + 1) * 64 + n];
            v[e] = mtp < 4 ? (cr * pr - ci * pi) : -(cr * pi + ci * pr); }
        v4u o; o.x = pk2(v[0], v[1]); o.y = pk2(v[2], v[3]); o.z = pk2(v[4], v[5]); o.w = pk2(v[6], v[7]);
        *(v4u*)(W3C + (size_t)id * 8) = o;
    }
    for (int id = tid; id < 16 * 64; id += 512) {
        const int dl = id >> 6, lane = id & 63, q = lane >> 4, p = lane & 15, lag = dl - (q >> 1); float v[8];
#pragma unroll
        for (int e = 0; e < 8; ++e) { const int pq = 8 * (q & 1) + e; float x = 0.f; if (lag >= 0) x = Kd[(lag * 16 + p) * 16 + pq]; if (lag == 0 && pq == p) x += dvec[g * 16 + p]; v[e] = x; }
        v4u o; o.x = pk2(v[0], v[1]); o.y = pk2(v[2], v[3]); o.z = pk2(v[4], v[5]); o.w = pk2(v[6], v[7]);
        *(v4u*)(W3T + (size_t)id * 8) = o;
    }
    __syncthreads();
}

__device__ __forceinline__ void p0_prologue(const Args& a, LAS unsigned char* lds, int tid, int lane, int wave, int G) {
#ifndef S5GEN_REPS
#define S5GEN_REPS 1
#endif
    for (int rr = 0; rr < S5GEN_REPS; ++rr)
    for (int g = blockIdx.x; g < 64; g += G) s5_gen(a, g, (LAS float*)lds, tid);
    __syncthreads();
    LAS float* scr = (LAS float*)(lds + wave * 16384);
    const int gw = blockIdx.x * NWAVES + wave, NGW = G * NWAVES;
    unsigned char* ws = WSP();
    constexpr int I_GU = (D / 64) * (FF / 32), I_DN = (FF / 64) * (D / 32), I_IN = (D / 64) * (DIN / 32), I_GLU = (DSSM / 64) * (DSSM / 32), I_OH = (1024 / 64) * (D / 32), I_PG = (D / 64) * (D / 32), I_PP = (DPLE / 64) * (D / 32);
    constexpr int NITEMS = 4 * I_GU + 2 * I_DN + I_IN + I_GLU + 2 * I_OH + I_PG + I_PP;
#ifndef TR_REPS
#define TR_REPS 1
#endif
    for (int trr = 0; trr < TR_REPS; ++trr)
    for (int it = gw; it < NITEMS; it += NGW) {
        int r = it;
        if (r < I_GU) { p0_transpose_item(INP(3), D, FF, (bf16*)(ws + WS_W1GU), INP(2), 1, scr, r, lane); continue; } r -= I_GU;
        if (r < I_GU) { p0_transpose_item(INP(4), D, FF, (bf16*)(ws + WS_W1GU), INP(2), 2, scr, r, lane); continue; } r -= I_GU;
        if (r < I_DN) { p0_transpose_item(INP(5), FF, D, (bf16*)(ws + WS_W1D), nullptr, 0, scr, r, lane); continue; } r -= I_DN;
        if (r < I_IN) { p0_transpose_item(INP(7), D, DIN, (bf16*)(ws + WS_WIN), INP(6), 0, scr, r, lane); continue; } r -= I_IN;
        if (r < I_GLU) { p0_transpose_item(INP(16), DSSM, DSSM, (bf16*)(ws + WS_WGLU), nullptr, 0, scr, r, lane); continue; } r -= I_GLU;
        if (r < I_OH) { p0_transpose_item(INP(22), 1024, D, (bf16*)(ws + WS_WO), INP(20), 0, scr, r, lane, D); continue; } r -= I_OH;
        if (r < I_OH) { p0_transpose_item(INP(22) + (size_t)1024 * D, 1024, D, (bf16*)(ws + WS_WO) + 1024, INP(21), 0, scr, r, lane, D); continue; } r -= I_OH;
        if (r < I_GU) { p0_transpose_item(INP(24), D, FF, (bf16*)(ws + WS_W2GU), INP(23), 1, scr, r, lane); continue; } r -= I_GU;
        if (r < I_GU) { p0_transpose_item(INP(25), D, FF, (bf16*)(ws + WS_W2GU), INP(23), 2, scr, r, lane); continue; } r -= I_GU;
        if (r < I_DN) { p0_transpose_item(INP(26), FF, D, (bf16*)(ws + WS_W2D), nullptr, 0, scr, r, lane); continue; } r -= I_DN;
        if (r < I_PG) { p0_transpose_item(INP(28), D, D, (bf16*)(ws + WS_WPG), INP(27), 0, scr, r, lane); continue; } r -= I_PG;
        p0_transpose_item(INP(29), DPLE, D, (bf16*)(ws + WS_WPP), nullptr, 0, scr, r, lane);
    }
    const float* x = INP(0); bf16* xb = (bf16*)(ws + WS_HB); float* hpA = (float*)(ws + WS_HPA);
    const int nskip = (G > 128) ? 64 : 0;
    const int gw2 = ((int)blockIdx.x - nskip) * NWAVES + wave, NGW2 = (G - nskip) * NWAVES;
    if ((int)blockIdx.x >= nskip)
    for (int m = gw2; m < M; m += NGW2) {
        const f32x4* xr = (const f32x4*)(x + (size_t)m * D) + lane; float s = 0.f;
        unsigned long long* o8 = (unsigned long long*)(xb + (size_t)m * D) + lane;
#pragma unroll
        for (int j = 0; j < 8; ++j) { const f32x4 v = xr[64 * j]; s += (v[0] * v[0] + v[1] * v[1]) + (v[2] * v[2] + v[3] * v[3]);
            o8[64 * j] = (unsigned long long)pk2(v[0], v[1]) | ((unsigned long long)pk2(v[2], v[3]) << 32); }
        s = wave_sum(s);
        if (lane < 32) hpA[(size_t)m * 32 + lane] = lane == 0 ? s : 0.f;
    }
    const float* p = INP(1); bf16* pb = (bf16*)(ws + WS_PB);
    if ((int)blockIdx.x >= nskip)
    for (size_t i = (size_t)gw2 * 64 + lane; i < (size_t)M * DPLE / 4; i += (size_t)NGW2 * 64) { const f32x4 v = ((const f32x4*)p)[i];
        ((unsigned long long*)pb)[i] = (unsigned long long)pk2(v[0], v[1]) | ((unsigned long long)pk2(v[2], v[3]) << 32); }
}

__device__ __forceinline__ void gmlp_phase(const Args& a, LAS unsigned char* lds, int tid, int lane, int wave, int G) {
    constexpr int VP = 136;
    LAS bf16* LV = (LAS bf16*)lds; LAS bf16* LW = (LAS bf16*)(lds + 128 * VP * 2); LAS float* ST = (LAS float*)(lds + 2 * 128 * VP * 2);
    unsigned char* ws = WSP();
    const bf16* gv = (const bf16*)(ws + WS_GV); bf16* gu = (bf16*)(ws + WS_YCAT) + 1024;     const float* lnp = (const float*)(ws + WS_LNP); float* gsp = (float*)(ws + WS_GSP);
    const float* normv = INP(17); const float* w_s = INP(18); const float* b_s = INP(19);
    const int fr = lane & 15, q = lane >> 4;
    int h_staged = -1;
    for (int unit = blockIdx.x; unit < 1024; unit += G) {
        const int h = unit & 7, m0 = (unit >> 3) * 128;
        if (tid < 128) { const f32x4* pp = (const f32x4*)(lnp + (size_t)(m0 + tid) * 32); float s1 = 0.f, s2 = 0.f;
#pragma unroll
            for (int i = 0; i < 8; ++i) { const f32x4 v = pp[i]; s1 += v[0] + v[2]; s2 += v[1] + v[3]; }
            const float mean = s1 * (1.0f / 1024.0f), var = s2 * (1.0f / 1024.0f) - mean * mean;
            ST[2 * tid] = mean; ST[2 * tid + 1] = rsqrtf(fmaxf(var, 0.f) + EPS); }
        __syncthreads();
#pragma unroll
        for (int i = 0; i < 2; ++i) { const int id = tid + 512 * i, s = 2 * (id >> 4), pc = id & 15;
            const v4u w0 = *(const v4u*)(gv + (size_t)(m0 + s) * 1024 + h * 128 + pc * 8), w1 = *(const v4u*)(gv + (size_t)(m0 + s + 1) * 1024 + h * 128 + pc * 8);
            const float mean0 = ST[2 * s], rstd0 = ST[2 * s + 1], mean1 = ST[2 * s + 2], rstd1 = ST[2 * s + 3];
            const f32x4 g0 = *(const f32x4*)(normv + h * 128 + pc * 8), g1 = *(const f32x4*)(normv + h * 128 + pc * 8 + 4);
            const float v0[8] = {bflo(w0.x), bfhi(w0.x), bflo(w0.y), bfhi(w0.y), bflo(w0.z), bfhi(w0.z), bflo(w0.w), bfhi(w0.w)};
            const float v1[8] = {bflo(w1.x), bfhi(w1.x), bflo(w1.y), bfhi(w1.y), bflo(w1.z), bfhi(w1.z), bflo(w1.w), bfhi(w1.w)};
#pragma unroll
            for (int e = 0; e < 8; ++e) { const float gg = e < 4 ? g0[e & 3] : g1[e & 3];
                *(LAS unsigned*)(LV + (pc * 8 + e) * VP + s) = pk2((v0[e] - mean0) * rstd0 * gg, (v1[e] - mean1) * rstd1 * gg); } }
        if (h != h_staged) { h_staged = h;
#pragma unroll
        for (int i = 0; i < 8; ++i) { const int id = tid + 512 * i, t = id >> 5, sc = id & 31;
            const f32x4 w = *(const f32x4*)(w_s + ((size_t)h * 128 + t) * 128 + sc * 4);
            float v[4];
#pragma unroll
            for (int e = 0; e < 4; ++e) v[e] = (sc * 4 + e <= t) ? w[e] : 0.f;
            *(LAS v2u*)(LW + t * VP + sc * 4) = (v2u){pk2(v[0], v[1]), pk2(v[2], v[3])}; }
        }
        __syncthreads();
        f32x4 acc[8];
#pragma unroll
        for (int pt = 0; pt < 8; ++pt) acc[pt] = (f32x4){0.f, 0.f, 0.f, 0.f};
        const int nks = (16 * wave + 15) / 32 + 1;
        for (int ks = 0; ks < nks; ++ks) {
            const bf16x8 wf = *(const LAS bf16x8*)(LW + (16 * wave + fr) * VP + ks * 32 + 8 * q);
#pragma unroll
            for (int pt = 0; pt < 8; ++pt) { const bf16x8 vf = *(const LAS bf16x8*)(LV + (16 * pt + fr) * VP + ks * 32 + 8 * q);
                acc[pt] = __builtin_amdgcn_mfma_f32_16x16x32_bf16(vf, wf, acc[pt], 0, 0, 0); }
        }
        const int t = 16 * wave + fr, row = m0 + t; const float bias = b_s[h * 128 + t]; float ss = 0.f;
#pragma unroll
        for (int pt = 0; pt < 8; ++pt) { bf16* gp = gu + (size_t)row * 2048 + h * 128 + 16 * pt + 4 * q; const v2u w = *(const v2u*)gp;
            const float o0 = bflo(w.x) * (acc[pt][0] + bias), o1 = bfhi(w.x) * (acc[pt][1] + bias), o2 = bflo(w.y) * (acc[pt][2] + bias), o3 = bfhi(w.y) * (acc[pt][3] + bias);
            ss += (o0 * o0 + o1 * o1) + (o2 * o2 + o3 * o3);
            *(v2u*)gp = (v2u){pk2(o0, o1), pk2(o2, o3)}; }
        ss += __shfl_xor(ss, 16); ss += __shfl_xor(ss, 32);
        if (q == 0) gsp[(size_t)row * 8 + h] = ss;
        __syncthreads();
    }
}

#if !S5_FAST
__device__ __forceinline__ void s5_phase(const Args& a, LAS unsigned char* lds, int tid, int lane, int wave, int G) {
    unsigned char* ws = WSP(); const bf16* zs = (const bf16*)(ws + WS_ZS); bf16* yg = (bf16*)(ws + WS_YG);
    const float* log_dt = INP(8); const float* a_re = INP(9); const float* a_im = INP(10); const float* b_re = INP(11); const float* b_im = INP(12);
    const float* c_re = INP(13); const float* c_im = INP(14); const float* dvec = INP(15);
    for (int job = blockIdx.x * NWAVES + wave; job < 256; job += G * NWAVES) {
        const int b = job >> 6, g = job & 63, n = lane;
        const float dt = expf(log_dt[g]), lr = fminf(a_re[g * 64 + n], -1e-4f), li = a_im[g * 64 + n];
        const float mag = expf(lr * dt), ang = li * dt, abr = mag * cosf(ang), abi = mag * sinf(ang);
        const float xr = abr - 1.0f, xi = abi, den = lr * lr + li * li, zr = (xr * lr + xi * li) / den, zi = (xi * lr - xr * li) / den;
        float bbr[16], bbi[16], cr[16], ci[16];
#pragma unroll
        for (int p = 0; p < 16; ++p) { const float br = b_re[(g * 64 + n) * 16 + p], bi = b_im[(g * 64 + n) * 16 + p]; bbr[p] = zr * br - zi * bi; bbi[p] = zr * bi + zi * br;
            cr[p] = c_re[(g * 16 + p) * 64 + n]; ci[p] = c_im[(g * 16 + p) * 64 + n]; }
        float sr = 0.f, si = 0.f;
        for (int t = 0; t < SEQ; ++t) {
            const size_t row = (size_t)b * SEQ + t;
            const v4u u0 = *(const v4u*)(zs + row * 1024 + 16 * g), u1 = *(const v4u*)(zs + row * 1024 + 16 * g + 8);
            const float uu[16] = {bflo(u0.x), bfhi(u0.x), bflo(u0.y), bfhi(u0.y), bflo(u0.z), bfhi(u0.z), bflo(u0.w), bfhi(u0.w), bflo(u1.x), bfhi(u1.x), bflo(u1.y), bfhi(u1.y), bflo(u1.z), bfhi(u1.z), bflo(u1.w), bfhi(u1.w)};
            float dr = 0.f, di = 0.f;
#pragma unroll
            for (int p = 0; p < 16; ++p) { dr += bbr[p] * uu[p]; di += bbi[p] * uu[p]; }
            const float nsr = abr * sr - abi * si + dr, nsi = abr * si + abi * sr + di; sr = nsr; si = nsi;
            float y[16];
#pragma unroll
            for (int p = 0; p < 16; ++p) { float v = wave_sum(cr[p] * sr - ci[p] * si); v += dvec[g * 16 + p] * uu[p]; y[p] = pg8::gelu_tanh(v); }
            if (lane == 0) { v4u o0, o1; o0.x = pk2(y[0], y[1]); o0.y = pk2(y[2], y[3]); o0.z = pk2(y[4], y[5]); o0.w = pk2(y[6], y[7]); o1.x = pk2(y[8], y[9]); o1.y = pk2(y[10], y[11]); o1.z = pk2(y[12], y[13]); o1.w = pk2(y[14], y[15]);
                *(v4u*)(yg + row * 1024 + 16 * g) = o0; *(v4u*)(yg + row * 1024 + 16 * g + 8) = o1; }
        }
    }
}
#else
template <int N> __device__ __forceinline__ float dpp_shr(float v) { return __int_as_float(__builtin_amdgcn_update_dpp(0, __float_as_int(v), 0x110 + N, 0xF, 0xF, true)); }

template <bool DO_Y> __device__ __forceinline__ void s5_superblock(const bf16* zs, bf16* yg, const LAS unsigned char* img, const LAS float* CST, LAS float* scp, size_t t0, int g, int lane, GAS f32x4* ebuf) {
    const int fr = lane & 15, q = lane >> 4;
    f32x4 E[8];
    if constexpr (!DO_Y) {
        bf16x8 U[8];
#pragma unroll
        for (int ks = 0; ks < 8; ++ks) U[ks] = *(const GAS bf16x8*)(zs + (t0 + 16 * fr + 2 * ks + (q >> 1)) * 1024 + 16 * g + 8 * (q & 1));
        const LAS bf16x8* w1p = (const LAS bf16x8*)(img + lane * 16);
#pragma unroll
        for (int mt = 0; mt < 8; ++mt) {
            E[mt] = (f32x4){0.f, 0.f, 0.f, 0.f};
#pragma unroll
            for (int ks = 0; ks < 8; ++ks) E[mt] = __builtin_amdgcn_mfma_f32_16x16x32_bf16(w1p[64 * (mt * 8 + ks)], U[ks], E[mt], 0, 0, 0);
            ebuf[64 * mt + lane] = E[mt];
            asm volatile("" ::: "memory");
        }
    } else {
#pragma unroll
        for (int mt = 0; mt < 8; ++mt) E[mt] = ebuf[64 * mt + lane];
    }
#pragma unroll
    for (int mt = 0; mt < 4; ++mt) { const f32x4 mr = *(const LAS f32x4*)(CST + 0 * 64 + 16 * mt + 4 * q), mi = *(const LAS f32x4*)(CST + 1 * 64 + 16 * mt + 4 * q);
        const f32x4 cr = *(const LAS f32x4*)(scp + 16 * mt + 4 * q), ci = *(const LAS f32x4*)(scp + 16 * (mt + 4) + 4 * q);
        if (fr == 0) { E[mt] += mr * cr - mi * ci; E[mt + 4] += mr * ci + mi * cr; } }
#define S5_LEVEL(LV, DD) { \
    _Pragma("unroll") for (int mt = 0; mt < 4; ++mt) { const f32x4 mr = *(const LAS f32x4*)(CST + ((LV) * 2 + 0) * 64 + 16 * mt + 4 * q), mi = *(const LAS f32x4*)(CST + ((LV) * 2 + 1) * 64 + 16 * mt + 4 * q); \
        _Pragma("unroll") for (int j = 0; j < 4; ++j) { const float sr = dpp_shr<DD>(E[mt][j]), si = dpp_shr<DD>(E[mt + 4][j]); \
            E[mt][j] += mr[j] * sr - mi[j] * si; E[mt + 4][j] += mr[j] * si + mi[j] * sr; } } }
    __builtin_amdgcn_sched_barrier(0); S5_LEVEL(0, 1) __builtin_amdgcn_sched_barrier(0); S5_LEVEL(1, 2) __builtin_amdgcn_sched_barrier(0); S5_LEVEL(2, 4) __builtin_amdgcn_sched_barrier(0); S5_LEVEL(3, 8) __builtin_amdgcn_sched_barrier(0);
#undef S5_LEVEL
    bf16x8 Sb[4];
    if constexpr (DO_Y) {
#pragma unroll
        for (int ks = 0; ks < 4; ++ks) { float x[8];
#pragma unroll
            for (int h = 0; h < 2; ++h) { const f32x4 c = *(const LAS f32x4*)(scp + 16 * (2 * ks + h) + 4 * q);
#pragma unroll
                for (int j = 0; j < 4; ++j) { const float sh = dpp_shr<1>(E[2 * ks + h][j]); x[4 * h + j] = fr == 0 ? c[j] : sh; } }
            v4u w; w.x = pg8::cvt_pk_bf16(x[0], x[1]); w.y = pg8::cvt_pk_bf16(x[2], x[3]); w.z = pg8::cvt_pk_bf16(x[4], x[5]); w.w = pg8::cvt_pk_bf16(x[6], x[7]);
            Sb[ks] = __builtin_bit_cast(bf16x8, w); }
    }
    asm volatile("s_waitcnt lgkmcnt(0)" ::: "memory");
    if (fr == 15) {
#pragma unroll
        for (int mt = 0; mt < 8; ++mt) *(LAS f32x4*)(scp + 16 * mt + 4 * q) = E[mt]; }
    if constexpr (DO_Y) {
        asm volatile("" ::: "memory");
        bf16x8 U2[8];
#pragma unroll
        for (int ks = 0; ks < 8; ++ks) U2[ks] = *(const GAS bf16x8*)(zs + (t0 + 16 * fr + 2 * ks + (q >> 1)) * 1024 + 16 * g + 8 * (q & 1));
        const LAS bf16x8* w3c = (const LAS bf16x8*)(img + 65536 + lane * 16);
        const LAS bf16x8* w3t = (const LAS bf16x8*)(img + 131072 + lane * 16);
        GAS v2u* yp = (GAS v2u*)(yg + (t0 + 16 * fr) * 1024 + 16 * g + 4 * q);
#pragma unroll
        for (int mt = 0; mt < 16; ++mt) {
            f32x4 acc = (f32x4){0.f, 0.f, 0.f, 0.f};
#pragma unroll
            for (int ks = 0; ks < 4; ++ks) acc = __builtin_amdgcn_mfma_f32_16x16x32_bf16(w3c[64 * (4 * mt + ks)], Sb[ks], acc, 0, 0, 0);
#pragma unroll
            for (int ks = 0; ks <= mt / 2; ++ks) acc = __builtin_amdgcn_mfma_f32_16x16x32_bf16(w3t[64 * (mt - 2 * ks)], U2[ks], acc, 0, 0, 0);
            const float y0 = pg8::gelu_tanh(acc[0]), y1 = pg8::gelu_tanh(acc[1]), y2 = pg8::gelu_tanh(acc[2]), y3 = pg8::gelu_tanh(acc[3]);
            yp[256 * mt] = (v2u){pg8::cvt_pk_bf16(y0, y1), pg8::cvt_pk_bf16(y2, y3)};
            asm volatile("" ::: "memory");
        }
    }
}

__device__ __forceinline__ void s5_fill_image(const unsigned char* ws, LAS unsigned char* lds, int g, int tid) {
    const GAS v4u* src = (const GAS v4u*)(ws + WS_S5W1 + (size_t)g * S5_IMG_BYTES) + tid; LAS v4u* dst = (LAS v4u*)lds + tid;
#pragma unroll 6
    for (int i = 0; i < S5_IMG_BYTES / 16 / 512; ++i) dst[512 * i] = src[512 * i];
}
__device__ __forceinline__ void s5_phase(const Args& a, LAS unsigned char* lds, int tid, int lane, int wave, int G, bool prefetched) {
    unsigned char* ws = WSP(); const bf16* zs = (const bf16*)(ws + WS_ZS); bf16* yg = (bf16*)(ws + WS_YG);
    LAS float* CST = (LAS float*)(lds + S5_IMG_BYTES); LAS float* ESEG = CST + 640; LAS float* SCW = ESEG + 1024;
    static_assert(S5_IMG_BYTES + (640 + 2048) * 4 <= MISC_OFF, "S5 LDS map");
    const int q = lane >> 4, fr = lane & 15;
    for (int job = blockIdx.x; job < 256; job += G) {
        const int b = job >> 6, g = job & 63;
        const float* SC = (const float*)(ws + WS_S5C) + (size_t)g * 640;
        for (int i = tid; i < 640; i += 512) CST[i] = SC[i];
        if (!(prefetched && job == (int)blockIdx.x)) s5_fill_image(ws, lds, g, tid);
        LAS float* eseg = ESEG + wave * 128; LAS float* scw = SCW + wave * 128;
        eseg[lane] = 0.f; eseg[64 + lane] = 0.f;
        __syncthreads();
        const size_t tb = (size_t)b * SEQ + 512 * wave;
        GAS f32x4* ebase = (GAS f32x4*)(ws + WS_HB) + ((size_t)job * NWAVES + wave) * 1024;
#ifndef NO_PASSA
#pragma unroll 1
        for (int sb = 0; sb < 2; ++sb) s5_superblock<false>(zs, yg, lds, CST, eseg, tb + 256 * sb, g, lane, ebase + 512 * sb);
#endif
        __syncthreads();
        if (fr == 0) {
            f32x4 sr[4], si[4];
#pragma unroll
            for (int mt = 0; mt < 4; ++mt) { sr[mt] = (f32x4){0.f, 0.f, 0.f, 0.f}; si[mt] = (f32x4){0.f, 0.f, 0.f, 0.f}; }
            for (int w2 = 0; w2 < wave; ++w2) {
#pragma unroll
                for (int mt = 0; mt < 4; ++mt) { const f32x4 mr = *(const LAS f32x4*)(CST + 8 * 64 + 16 * mt + 4 * q), mi = *(const LAS f32x4*)(CST + 9 * 64 + 16 * mt + 4 * q);
                    const f32x4 er = *(const LAS f32x4*)(ESEG + w2 * 128 + 16 * mt + 4 * q), ei = *(const LAS f32x4*)(ESEG + w2 * 128 + 16 * (mt + 4) + 4 * q);
                    const f32x4 nr = mr * sr[mt] - mi * si[mt] + er, ni = mr * si[mt] + mi * sr[mt] + ei; sr[mt] = nr; si[mt] = ni; }
            }
#pragma unroll
            for (int mt = 0; mt < 4; ++mt) { *(LAS f32x4*)(scw + 16 * mt + 4 * q) = sr[mt]; *(LAS f32x4*)(scw + 16 * (mt + 4) + 4 * q) = si[mt]; }
        }
#ifndef NO_PASSC
#pragma unroll 1
        for (int sb = 0; sb < 2; ++sb) s5_superblock<true>(zs, yg, lds, CST, scw, tb + 256 * sb, g, lane, ebase + 512 * sb);
#endif
        __syncthreads();
    }
}
#endif

__device__ __forceinline__ void final_phase(const Args& a, int lane, int wave, int G, int c_x, bool loc_ok) {
    const float* hp = (const float*)(WSP() + WS_HPA); const float* gf = INP(30); float* out = OUTP();
    const int nw = loc_ok ? (G / 8) * NWAVES : G * NWAVES, w0 = loc_ok ? (c_x >> 3) * NWAVES + wave : (int)blockIdx.x * NWAVES + wave;
    const int mbase = loc_ok ? (c_x & 7) * (M / 8) : 0, mcnt = loc_ok ? M / 8 : M;
    for (int mi = w0; mi < mcnt; mi += nw) {
        const int m = mbase + mi;
        float s = lane < 32 ? hp[(size_t)m * 32 + lane] : 0.f; s = wave_sum(s);
        const float r = rsqrtf(s * (1.0f / 2048.0f) + EPS);
        f32x4* o = (f32x4*)(out + (size_t)m * D) + lane; const f32x4* gg = (const f32x4*)gf + lane;
#pragma unroll
        for (int j = 0; j < 8; ++j) { const f32x4 v = o[64 * j], w = gg[64 * j]; o[64 * j] = v * r * w; }
    }
}

struct RevOrder { pg8::StaticOrder b; int n;
    __device__ __forceinline__ bool next(int i, pg8::Unit& u) const { if (i >= n) return false; return b.next(n - 1 - i, u); }
    __device__ __forceinline__ void a_ready(const pg8::Unit&) const {}
    __device__ __forceinline__ void done(const pg8::Unit&) const {} };

constexpr int N_PHASES = 12;
__global__ void __launch_bounds__(NWAVES * 64, 2) fwd_kernel(Args args) {
    extern __shared__ __attribute__((aligned(16))) unsigned char lds_raw[];
    LAS unsigned char* lds = (LAS unsigned char*)lds_raw;
    const int tid = threadIdx.x, lane = tid & 63, wave = __builtin_amdgcn_readfirstlane(tid >> 6), G = gridDim.x, c = blockIdx.x;
    unsigned char* ws = WSP();
    const int lo = KARG_INT(66), hi = KARG_INT(67);
    cg::grid_group grid = cg::this_grid();
    volatile LAS unsigned* MISC = (volatile LAS unsigned*)(lds + MISC_OFF);
    if (tid < 16) MISC[tid] = 0u;
    __syncthreads();
    unsigned* barw = (unsigned*)(WSP() + 16384);
    XcdBarrier bar; bar.bar = barw; bar.x = 0; bar.st = nullptr;
#ifndef PHMASK
#define PHMASK 0xFFFF
#endif
#define IN(k) (((PHMASK >> (k)) & 1) && lo <= (k) && (k) < hi)
#define SEAM(k) do { if (IN(k) && IN((k) + 1)) xcd_barrier(bar); } while (0)
#define SEAM_L(k) do { if (IN(k) && IN((k) + 1)) { if (loc_ok) xcd_local_barrier(bar); else xcd_barrier(bar); } } while (0)
#ifndef REPMASK
#define REPMASK 0
#endif
#define REP(k) ((REPMASK >> (k)) & 1)
#ifndef EXTRA_SYNCS
#define EXTRA_SYNCS 0
#endif
    bf16* hb = (bf16*)(ws + WS_HB); bf16* act = (bf16*)(ws + WS_ACT); float* hpA = (float*)(ws + WS_HPA); float* hpB = (float*)(ws + WS_HPB);
    bf16* ppb = (bf16*)(ws + WS_PP);

    for (int i = 0; i < EXTRA_SYNCS; ++i) grid.sync();
    bool s5_pref = false;
    for (int rep = 0; rep <= REP(0); ++rep) { if (rep) grid.sync();
    if (IN(0)) { if (blockIdx.x == 0) for (int i = tid; i < XCD_BAR_WORDS; i += NWAVES * 64) barw[i] = 0u;
        p0_prologue(args, lds, tid, lane, wave, G); } }
    int c_x = c; bool loc_ok = false;
    if (IN(0) && IN(1)) { grid.sync(); bar = xcd_barrier_post(barw, MISC + 8);
        if (tid == 0) { unsigned nloc, nx; xcd_barrier_complete(barw, bar.x, nloc, nx); MISC[8] = nloc; MISC[9] = nx; }
        __syncthreads();
        bool ok = (G % 8 == 0);
#pragma unroll
        for (unsigned j = 0; j < 16; ++j) { const unsigned cn = xb_ld(&barw[XB_XCNT(j)]); ok = ok && (cn == (j < 8 ? (unsigned)G / 8u : 0u)); }
        const unsigned rank = MISC[10];
#ifndef NO_LOCAL_SEAMS
        const int okf = __builtin_amdgcn_readfirstlane((ok && rank < (unsigned)G / 8u && MISC[8] == (unsigned)G / 8u) ? 1 : 0);
        if (okf) { c_x = __builtin_amdgcn_readfirstlane((int)(bar.x + 8u * rank)); loc_ok = true; }
#endif
    }
    for (int rep = 0; rep <= REP(1); ++rep) { if (rep) grid.sync();
    if (IN(1)) {
        { pg8::Gemm g{(const bf16*)(ws + WS_PB), (const bf16*)(ws + WS_WPP), M, D, DPLE}; pg8::StaticOrder S; S.init(M, D, G, c_x); pg8::EpiPlain E{ppb, D};
          pg8::gemm_phase<pg8::EpiPlain, pg8::StaticOrder, GP_ALIGN, GP_SP2>(lds, g, S, E); }
        { pg8::Gemm g{hb, (const bf16*)(ws + WS_W1GU), M, 2 * FF, D}; pg8::StaticOrder S; S.init(M, 2 * FF, G, c_x, WGM_UP); pg8::EpiSwiglu E{act, hpA, FF};
          pg8::gemm_phase<pg8::EpiSwiglu, pg8::StaticOrder, GP_ALIGN, GP_SP2>(lds, g, S, E); }
    } }
    SEAM_L(1);
    for (int rep = 0; rep <= REP(2); ++rep) { if (rep) grid.sync();
    if (IN(2)) {
        pg8::Gemm g{act, (const bf16*)(ws + WS_W1D), M, D, FF}; RevOrder S; S.b.init(M, D, G, c_x, WGM_DN); S.n = ((M / 256) * (D / 256) + G - 1 - c_x) / G;
        pg8::EpiRes<0, false, true, true> E{INP(0), OUTP(), hb, hpB, nullptr, nullptr, 0.5f, 0.f};
        pg8::gemm_phase<pg8::EpiRes<0, false, true, true>, RevOrder, GP_ALIGN_RES, GP_SP2>(lds, g, S, E);
    } }
    SEAM(2);
    if (IN(3)) {
        pg8::Gemm g{hb, (const bf16*)(ws + WS_WIN), M, DIN, D}; pg8::StaticOrder S; S.init(M, DIN, G, c_x);
        pg8::EpiWin E{(bf16*)(ws + WS_ZS), (WS_YCAT - WS_ZS) / 2 + 1024, (WS_GV - WS_ZS) / 2, (float*)(ws + WS_LNP), hpB};
        pg8::gemm_phase<pg8::EpiWin, pg8::StaticOrder, GP_ALIGN, GP_SP2>(lds, g, S, E);
#if S5_FAST
        if (IN(4) && (int)blockIdx.x < 256) { s5_fill_image(ws, lds, (int)blockIdx.x & 63, tid); s5_pref = true; }
#endif
    }
    SEAM(3);
    if (IN(4)) { for (int rep = 0; rep <= REP(4); ++rep) { s5_phase(args, lds, tid, lane, wave, G, s5_pref && rep == 0); __syncthreads(); }
#ifndef NO_GMLP
 gmlp_phase(args, lds, tid, lane, wave, G);
#endif
 }
    SEAM(4);
    if (IN(5)) {
        pg8::Gemm g{(const bf16*)(ws + WS_YG), (const bf16*)(ws + WS_WGLU), M, DSSM, DSSM}; pg8::StaticOrder S; S.init(M, DSSM, G, c_x);
        pg8::EpiGlu E{(const bf16*)(ws + WS_YG), (bf16*)(ws + WS_YCAT), (float*)(ws + WS_SSP)};
        pg8::gemm_phase<pg8::EpiGlu, pg8::StaticOrder, GP_ALIGN, GP_SP2>(lds, g, S, E);
    }
    SEAM_L(5);
    if (IN(6)) {
        LAS float* midtab = (LAS float*)(lds + RING_BYTES);
        pg8::StaticOrder S; S.init(M, D, G, c_x);
        { const float* ssp = (const float*)(ws + WS_SSP); const float* gsp = (const float*)(ws + WS_GSP);
          for (int i = tid >> 8; i < 8; i += 2) { pg8::Unit u; if (!S.next(i, u)) break; const int row = u.pm * 256 + (tid & 255);
              const f32x4* sp = (const f32x4*)(ssp + (size_t)row * 16); const f32x4* gp = (const f32x4*)(gsp + (size_t)row * 8); float ssum = 0.f, gsum = 0.f;
#pragma unroll
              for (int j = 0; j < 4; ++j) { const f32x4 v = sp[j]; ssum += (v[0] + v[1]) + (v[2] + v[3]); }
#pragma unroll
              for (int j = 0; j < 2; ++j) { const f32x4 v = gp[j]; gsum += (v[0] + v[1]) + (v[2] + v[3]); }
              midtab[i * 256 + (tid & 255)] = sqrtf((gsum * (1.0f / 1024.0f) + EPS) / (ssum * (1.0f / 1024.0f) + EPS)); }
          __syncthreads(); }
        pg8::Gemm g{(const bf16*)(ws + WS_YCAT), (const bf16*)(ws + WS_WO), M, D, D};
        pg8::EpiRes<8, false, true, true> E{OUTP(), OUTP(), hb, hpA, (const float*)(ws + WS_GSP), nullptr, 0.f, 1.0f / 1024.0f};
        pg8::gemm_phase<pg8::EpiRes<8, false, true, true>, pg8::StaticOrder, GP_ALIGN_RES, GP_SP2, true>(lds, g, S, E, midtab);
    }
    SEAM(6);
    if (IN(7)) {
        pg8::Gemm g{hb, (const bf16*)(ws + WS_W2GU), M, 2 * FF, D}; pg8::StaticOrder S; S.init(M, 2 * FF, G, c_x, WGM_UP); pg8::EpiSwiglu E{act, hpA, FF};
        pg8::gemm_phase<pg8::EpiSwiglu, pg8::StaticOrder, GP_ALIGN, GP_SP2>(lds, g, S, E);
    }
    SEAM_L(7);
    if (IN(8)) {
        pg8::Gemm g{act, (const bf16*)(ws + WS_W2D), M, D, FF}; RevOrder S; S.b.init(M, D, G, c_x, WGM_DN); S.n = ((M / 256) * (D / 256) + G - 1 - c_x) / G;
        pg8::EpiRes<0, false, true, true> E{OUTP(), OUTP(), hb, hpB, nullptr, nullptr, 0.5f, 0.f};
        pg8::gemm_phase<pg8::EpiRes<0, false, true, true>, RevOrder, GP_ALIGN_RES, GP_SP2>(lds, g, S, E);
    }
    SEAM_L(8);
    if (IN(9)) {
        pg8::Gemm g{hb, (const bf16*)(ws + WS_WPG), M, D, D}; pg8::StaticOrder S; S.init(M, D, G, c_x);
        pg8::EpiRes<32, true, false, true> E{OUTP(), OUTP(), nullptr, hpA, hpB, ppb, 0.f, 1.0f / 2048.0f};
        pg8::gemm_phase<pg8::EpiRes<32, true, false, true>, pg8::StaticOrder, GP_ALIGN_RES, GP_SP2>(lds, g, S, E);
    }
    SEAM_L(9);
    if (IN(10)) { final_phase(args, lane, wave, G, c_x, loc_ok); }
#undef IN
#undef SEAM
}

extern "C" void kernel_launch(void* const* d_in, const int* in_sizes, int n_in, void* d_out, int out_size, void* d_ws, size_t ws_size, hipStream_t stream) {
    if (n_in != 31 || out_size != M * D || ws_size < WS_END) { fprintf(stderr, "kernel_launch: unexpected shapes (n_in %d out %d ws %zu)\n", n_in, out_size, ws_size); return; }
    static int grid = 0;
    if (grid == 0) {
        int dev = 0, cus = 0, per_cu = 0;
        (void)hipGetDevice(&dev); (void)hipDeviceGetAttribute(&cus, hipDeviceAttributeMultiprocessorCount, dev);
        (void)hipFuncSetAttribute((const void*)fwd_kernel, hipFuncAttributeMaxDynamicSharedMemorySize, LDS_BYTES);
        (void)hipOccupancyMaxActiveBlocksPerMultiprocessor(&per_cu, (const void*)fwd_kernel, NWAVES * 64, LDS_BYTES);
        if (per_cu < 1) { fprintf(stderr, "kernel_launch: occupancy query says %d blocks/CU\n", per_cu); per_cu = 1; }
        (void)hipGetLastError();
        grid = cus * 1;
    }
    Args a{};
    for (int i = 0; i < 31; ++i) a.in[i] = (const float*)d_in[i];
    a.out = (float*)d_out; a.ws = (unsigned char*)d_ws;
#if ONE_LAUNCH
    a.ph_lo = 0; a.ph_hi = N_PHASES;
    void* kargs[] = {&a};
    hipError_t e = hipLaunchCooperativeKernel((const void*)fwd_kernel, dim3(grid), dim3(NWAVES * 64), kargs, LDS_BYTES, stream);
    if (e != hipSuccess) fprintf(stderr, "cooperative launch failed: %s (grid %d)\n", hipGetErrorString(e), grid);
#else
    for (int ph = 0; ph < 11; ++ph) { a.ph_lo = ph; a.ph_hi = ph + 1; hipLaunchKernelGGL(fwd_kernel, dim3(grid), dim3(NWAVES * 64), LDS_BYTES, stream, a); }
#endif
}
```
